# Optimizing an MI355X kernel written in HIP

```python
import math
import jax, jax.numpy as jnp
from jax import lax
import numpy as np

D_MODEL = 1024
BATCH = 8
SEQ = 2048
DEPTH = 2
DEC_BATCH = 128
DEC_SEQ = 1
PAST_LEN = 16384
PAGE_SIZE = 128

N_EVEN = (DEPTH + 1) // 2
N_ODD = DEPTH // 2
MH = 4
MLSTM_DIM = D_MODEL
MDK = MLSTM_DIM // MH
MDV = MLSTM_DIM // MH
GATE_CAP = 15.0
SSM_DIM = D_MODEL
SP = 64
SH = SSM_DIM // SP
SG = 2
SN = 128
CONV_W = 4
CONV_DIM = SSM_DIM + 2 * SG * SN
IN_DIM = 4 * MLSTM_DIM + 2 * MH + SSM_DIM + CONV_DIM + SH
MIX_DIM = MLSTM_DIM + SSM_DIM
POOL_WINDOWS = (2, 4, 8, 16)
POOL_GROUPS = 4
POOL_C = D_MODEL // POOL_GROUPS
POOL_BUF = max(POOL_WINDOWS) - 1
FF = -(-8 * D_MODEL // (3 * 256)) * 256
CHUNK = 64
EPS = 1e-6

kernel_name = 'mlstm_ssd_pool_hybrid_step'

F32 = jnp.float32


def _rmsnorm(x, g):
    xf = x.astype(F32)
    y = xf * lax.rsqrt(jnp.mean(xf * xf, axis=-1, keepdims=True) + EPS)
    return (y * g.astype(F32)).astype(x.dtype)


def _softcap(x):
    return GATE_CAP * jnp.tanh(x / GATE_CAP)


def _chunk_len(t):
    return CHUNK if t % CHUNK == 0 else t


def _mlstm(q, k, v, logi, logf, c0, n0, m0):
    B, T, H, DK = q.shape
    DV = v.shape[-1]
    L = _chunk_len(T)
    NC = T // L

    def blk(a):
        a = a.reshape((B, NC, L, H) + a.shape[3:])
        return a.transpose((1, 0, 3, 2) + tuple(range(4, a.ndim)))

    mask = jnp.tril(jnp.ones((L, L), bool))

    def step(carry, inp):
        c, n, m = carry
        qc, kc, vc, li, lf = inp
        b = jnp.cumsum(lf, axis=-1)
        dlog = jnp.where(mask, b[..., :, None] - b[..., None, :] + li[..., None, :], -jnp.inf)
        inter = b + m[..., None]
        mt = jnp.maximum(inter, jnp.max(dlog, axis=-1))
        s = jnp.einsum('bhtd,bhsd->bhts', qc, kc) * jnp.exp(dlog - mt[..., None])
        iw = jnp.exp(inter - mt)
        num = jnp.einsum('bhts,bhsv->bhtv', s, vc) + iw[..., None] * jnp.einsum('bhtd,bhdv->bhtv', qc, c)
        den = jnp.sum(s, axis=-1) + iw * jnp.einsum('bhtd,bhd->bht', qc, n)
        h = num / jnp.maximum(jnp.abs(den), jnp.exp(-mt))[..., None]
        bl = b[..., -1]
        g = bl[..., None] - b + li
        m_new = jnp.maximum(bl + m, jnp.max(g, axis=-1))
        w = jnp.exp(g - m_new[..., None])
        dec = jnp.exp(bl + m - m_new)
        c_new = dec[..., None, None] * c + jnp.einsum('bhs,bhsd,bhsv->bhdv', w, kc, vc)
        n_new = dec[..., None] * n + jnp.einsum('bhs,bhsd->bhd', w, kc)
        return (c_new, n_new, m_new), h

    xs = (blk(q.astype(F32)), blk(k.astype(F32)), blk(v.astype(F32)), blk(logi), blk(logf))
    (c, n, m), h = lax.scan(step, (c0.astype(F32), n0.astype(F32), m0.astype(F32)), xs)
    h = h.transpose(1, 0, 3, 2, 4).reshape(B, T, H, DV)
    return h, c, n, m


def _ssd(x, dt, a, bm, cm, h0):
    B, T, H, P = x.shape
    G, N = bm.shape[2], bm.shape[3]
    E = H // G
    L = _chunk_len(T)
    NC = T // L
    xb = x.astype(F32).reshape(B, NC, L, G, E, P).transpose(1, 0, 3, 4, 2, 5)
    dtb = dt.reshape(B, NC, L, G, E).transpose(1, 0, 3, 4, 2)
    ab = a.reshape(B, NC, L, G, E).transpose(1, 0, 3, 4, 2)
    bb = bm.astype(F32).reshape(B, NC, L, G, N).transpose(1, 0, 3, 2, 4)
    cb = cm.astype(F32).reshape(B, NC, L, G, N).transpose(1, 0, 3, 2, 4)
    mask = jnp.tril(jnp.ones((L, L), bool))

    def step(h, inp):
        xc, dtc, ac, bc, cc = inp
        cum = jnp.cumsum(ac, axis=-1)
        decay = jnp.exp(jnp.where(mask, cum[..., :, None] - cum[..., None, :], -jnp.inf))
        w = jnp.einsum('bgtn,bgsn->bgts', cc, bc)[:, :, None] * decay * dtc[..., None, :]
        y = jnp.einsum('bgets,bgesp->bgetp', w, xc) + jnp.exp(cum)[..., None] * jnp.einsum('bgtn,bgepn->bgetp', cc, h)
        wend = jnp.exp(cum[..., -1:] - cum) * dtc
        h_new = jnp.exp(cum[..., -1])[..., None, None] * h + jnp.einsum('bges,bgesp,bgsn->bgepn', wend, xc, bc)
        return h_new, y

    h, y = lax.scan(step, h0.astype(F32).reshape(B, G, E, P, N), (xb, dtb, ab, bb, cb))
    y = y.transpose(1, 0, 4, 2, 3, 5).reshape(B, T, H, P)
    return y, h.reshape(B, H, P, N)


def _causal_conv(xbc, buf, w, b):
    T = xbc.shape[1]
    ext = jnp.concatenate([buf.astype(xbc.dtype), xbc], axis=1)
    y = sum(ext[:, j:j + T] * w[j] for j in range(CONV_W)) + b
    return jax.nn.silu(y), ext[:, -(CONV_W - 1):]


def _mixer_ab(u, c0, n0, m0, h0, cbuf, w_in, b_ig, b_fg, g_mh, conv_w, conv_b, dt_bias, a_log, d_skip, g_ssm, w_out):
    B, T, _ = u.shape
    proj = jnp.einsum('btd,de->bte', u, w_in)
    sizes = (MLSTM_DIM, MLSTM_DIM, MLSTM_DIM, MLSTM_DIM, MH, MH, SSM_DIM, CONV_DIM, SH)
    q, k, v, o, ig, fg, z, xbc, dtr = jnp.split(proj, np.cumsum(sizes)[:-1].tolist(), axis=-1)
    logi = _softcap(ig.astype(F32) + b_ig.astype(F32))
    logf = jax.nn.log_sigmoid(_softcap(fg.astype(F32) + b_fg.astype(F32)))
    hq = q.reshape(B, T, MH, MDK) * (MDK ** -0.5)
    h, c, n, m = _mlstm(hq, k.reshape(B, T, MH, MDK), v.reshape(B, T, MH, MDV), logi, logf, c0, n0, m0)
    h = _rmsnorm(h.astype(u.dtype), g_mh.reshape(MH, MDV)).reshape(B, T, MLSTM_DIM) * jax.nn.sigmoid(o)
    xbc, cbuf_new = _causal_conv(xbc, cbuf, conv_w, conv_b)
    xs, bm, cm = jnp.split(xbc, [SSM_DIM, SSM_DIM + SG * SN], axis=-1)
    dt = jax.nn.softplus(dtr.astype(F32) + dt_bias.astype(F32))
    A = -jnp.exp(a_log.astype(F32))
    xh = xs.reshape(B, T, SH, SP)
    y, hs = _ssd(xh, dt, dt * A, bm.reshape(B, T, SG, SN), cm.reshape(B, T, SG, SN), h0)
    y = (y + d_skip.astype(F32)[:, None] * xh.astype(F32)).astype(u.dtype).reshape(B, T, SSM_DIM) * jax.nn.silu(z)
    y = _rmsnorm(y.reshape(B, T, SG, SSM_DIM // SG), g_ssm.reshape(SG, SSM_DIM // SG)).reshape(B, T, SSM_DIM)
    out = jnp.einsum('bte,ed->btd', jnp.concatenate([h, y], axis=-1), w_out)
    return out, c, n, m, hs, cbuf_new


def _mixer_pool(u, buf, start, w_pool, scale):
    B, T, D = u.shape
    ext = jnp.concatenate([buf.astype(u.dtype), u], axis=1)
    csum = lax.cumsum(ext.astype(F32), axis=1)
    csum = jnp.concatenate([jnp.zeros((B, 1, D), F32), csum], axis=1)
    hi = csum[:, POOL_BUF + 1:]
    pos = start + jnp.arange(T)
    parts = []
    for g, w in enumerate(POOL_WINDOWS):
        sl = slice(g * POOL_C, (g + 1) * POOL_C)
        lo = csum[:, POOL_BUF + 1 - w:POOL_BUF + 1 - w + T, sl]
        cnt = jnp.minimum(pos + 1, w).astype(F32)
        parts.append((hi[..., sl] - lo) / cnt[None, :, None])
    pooled = jnp.concatenate(parts, axis=-1)
    d = (pooled - u.astype(F32)).astype(u.dtype).reshape(B, T, POOL_GROUPS, POOL_C)
    out = jnp.einsum('btgc,gce->btge', d, w_pool).reshape(B, T, D) * scale
    return out, ext[:, -POOL_BUF:]


def _ffn(u, wg, wu, wd):
    return jnp.einsum('btf,fd->btd', jax.nn.silu(u @ wg) * (u @ wu), wd)


def _trunk(x, st_c, st_n, st_m, st_ssm, st_conv, st_pool, start, p):
    cs, ns, ms, hss, cvs, pls = [], [], [], [], [], []
    dt = x.dtype
    for l in range(DEPTH):
        u = _rmsnorm(x, p['g_mix_pre'][l])
        if l % 2 == 0:
            e = l // 2
            mix, c, n, m, hs, cb = _mixer_ab(u, st_c[e], st_n[e], st_m[e], st_ssm[e], st_conv[e],
                                             p['w_in_ab'][e], p['b_igate'][e], p['b_fgate'][e], p['g_mlstm'][e],
                                             p['conv_w'][e], p['conv_b'][e], p['dt_bias'][e], p['a_log'][e],
                                             p['d_skip'][e], p['g_ssm'][e], p['w_out_ab'][e])
            cs.append(c.astype(dt)); ns.append(n.astype(dt)); ms.append(m.astype(dt))
            hss.append(hs.astype(dt)); cvs.append(cb.astype(dt))
        else:
            o = l // 2
            mix, pb = _mixer_pool(u, st_pool[o], start, p['w_pool'][o], p['pool_scale'][o])
            pls.append(pb.astype(dt))
        x = x + _rmsnorm(mix, p['g_mix_post'][l])
        u = _rmsnorm(x, p['g_ffn_pre'][l])
        x = x + _rmsnorm(_ffn(u, p['w_gate'][l], p['w_up'][l], p['w_down'][l]), p['g_ffn_post'][l])
    return x, jnp.stack(cs), jnp.stack(ns), jnp.stack(ms), jnp.stack(hss), jnp.stack(cvs), jnp.stack(pls)


def setup_inputs(seed: int = 0) -> dict:
    key = jax.random.key(seed)
    ks = iter(jax.random.split(key, 32))

    def nrm(shape, s=1.0):
        return s * jax.random.normal(next(ks), shape, F32)

    x_prompt = nrm((BATCH, SEQ, D_MODEL))
    x_sample = nrm((DEC_BATCH, DEC_SEQ, D_MODEL))
    state_mlstm_c = nrm((N_EVEN, DEC_BATCH, MH, MDK, MDV), 0.1)
    state_mlstm_n = nrm((N_EVEN, DEC_BATCH, MH, MDK), 0.1)
    state_mlstm_m = nrm((N_EVEN, DEC_BATCH, MH))
    state_ssm = nrm((N_EVEN, DEC_BATCH, SH, SP, SN), 0.1)
    state_conv = nrm((N_EVEN, DEC_BATCH, CONV_W - 1, CONV_DIM))
    state_pool = nrm((N_ODD, DEC_BATCH, POOL_BUF, D_MODEL))
    g_mix_pre = 1.0 + nrm((DEPTH, D_MODEL), 0.05)
    g_mix_post = 1.0 + nrm((DEPTH, D_MODEL), 0.05)
    g_ffn_pre = 1.0 + nrm((DEPTH, D_MODEL), 0.05)
    g_ffn_post = 1.0 + nrm((DEPTH, D_MODEL), 0.05)
    w_in_ab = nrm((N_EVEN, D_MODEL, IN_DIM), D_MODEL ** -0.5)
    b_igate = nrm((N_EVEN, MH), 0.1)
    b_fgate = jnp.linspace(3.0, 6.0, MH, dtype=F32)[None, :] + nrm((N_EVEN, MH), 0.1)
    g_mlstm = 1.0 + nrm((N_EVEN, MLSTM_DIM), 0.05)
    conv_w = nrm((N_EVEN, CONV_W, CONV_DIM), CONV_W ** -0.5)
    conv_b = nrm((N_EVEN, CONV_DIM), 0.01)
    dt0 = jnp.exp(jax.random.uniform(next(ks), (N_EVEN, SH), F32, math.log(1e-3), math.log(1e-1)))
    dt_bias = dt0 + jnp.log(-jnp.expm1(-dt0))
    a_log = jnp.log(jax.random.uniform(next(ks), (N_EVEN, SH), F32, 1.0, 16.0))
    d_skip = 1.0 + nrm((N_EVEN, SH), 0.1)
    g_ssm = 1.0 + nrm((N_EVEN, SSM_DIM), 0.05)
    w_out_ab = nrm((N_EVEN, MIX_DIM, D_MODEL), MIX_DIM ** -0.5)
    w_pool = nrm((N_ODD, POOL_GROUPS, POOL_C, POOL_C), POOL_C ** -0.5)
    pool_scale = 1.0 + nrm((N_ODD, D_MODEL), 0.1)
    w_gate = nrm((DEPTH, D_MODEL, FF), D_MODEL ** -0.5)
    w_up = nrm((DEPTH, D_MODEL, FF), D_MODEL ** -0.5)
    w_down = nrm((DEPTH, FF, D_MODEL), FF ** -0.5)
    return {'x_prompt': x_prompt, 'x_sample': x_sample,
            'state_mlstm_c': state_mlstm_c, 'state_mlstm_n': state_mlstm_n, 'state_mlstm_m': state_mlstm_m,
            'state_ssm': state_ssm, 'state_conv': state_conv, 'state_pool': state_pool,
            'g_mix_pre': g_mix_pre, 'g_mix_post': g_mix_post, 'g_ffn_pre': g_ffn_pre, 'g_ffn_post': g_ffn_post,
            'w_in_ab': w_in_ab, 'b_igate': b_igate, 'b_fgate': b_fgate, 'g_mlstm': g_mlstm,
            'conv_w': conv_w, 'conv_b': conv_b, 'dt_bias': dt_bias, 'a_log': a_log, 'd_skip': d_skip,
            'g_ssm': g_ssm, 'w_out_ab': w_out_ab, 'w_pool': w_pool, 'pool_scale': pool_scale,
            'w_gate': w_gate, 'w_up': w_up, 'w_down': w_down}


def reference(x_prompt, x_sample, state_mlstm_c, state_mlstm_n, state_mlstm_m, state_ssm, state_conv, state_pool,
              g_mix_pre, g_mix_post, g_ffn_pre, g_ffn_post, w_in_ab, b_igate, b_fgate, g_mlstm,
              conv_w, conv_b, dt_bias, a_log, d_skip, g_ssm, w_out_ab, w_pool, pool_scale,
              w_gate, w_up, w_down):
    p = dict(g_mix_pre=g_mix_pre, g_mix_post=g_mix_post, g_ffn_pre=g_ffn_pre, g_ffn_post=g_ffn_post,
             w_in_ab=w_in_ab, b_igate=b_igate, b_fgate=b_fgate, g_mlstm=g_mlstm, conv_w=conv_w, conv_b=conv_b,
             dt_bias=dt_bias, a_log=a_log, d_skip=d_skip, g_ssm=g_ssm, w_out_ab=w_out_ab,
             w_pool=w_pool, pool_scale=pool_scale, w_gate=w_gate, w_up=w_up, w_down=w_down)
    dt = x_prompt.dtype
    z_c = jnp.zeros((N_EVEN, BATCH, MH, MDK, MDV), dt)
    z_n = jnp.zeros((N_EVEN, BATCH, MH, MDK), dt)
    z_m = jnp.zeros((N_EVEN, BATCH, MH), dt)
    z_ssm = jnp.zeros((N_EVEN, BATCH, SH, SP, SN), dt)
    z_conv = jnp.zeros((N_EVEN, BATCH, CONV_W - 1, CONV_DIM), dt)
    z_pool = jnp.zeros((N_ODD, BATCH, POOL_BUF, D_MODEL), dt)
    y_prompt, pc, pn, pm, pssm, pconv, ppool = _trunk(x_prompt, z_c, z_n, z_m, z_ssm, z_conv, z_pool, 0, p)
    y_sample, sc, sn, sm, sssm, sconv, spool = _trunk(x_sample, state_mlstm_c, state_mlstm_n, state_mlstm_m,
                                                     state_ssm, state_conv, state_pool, PAST_LEN, p)
    return (y_prompt, y_sample, pc, sc, pn, sn, pm, sm, pssm, sssm, pconv, sconv, ppool, spool)
```

```cpp
#include <hip/hip_runtime.h>
#include <cstdio>
#include <cstring>
#include <cstdint>
namespace pg8 {
#define PG8_LAS __attribute__((address_space(3)))
typedef unsigned short bf16_t;
typedef short bf16x8 __attribute__((ext_vector_type(8)));
typedef float f32x4 __attribute__((ext_vector_type(4)));
typedef float f32x2 __attribute__((ext_vector_type(2)));
typedef unsigned u32x4 __attribute__((ext_vector_type(4)));
constexpr int BM = 256, BK = 64, HALF = 128, HTB = HALF * BK * 2  , STAGE_BYTES = 8 * HTB, NXCD = 8, WGM = 8;

__host__ __device__ __forceinline__ int lds_byte(int r, int c) { const int st = (r >> 4) * 2 + (c >> 5), rr = r & 15, cc = c & 31, ob = rr * 64 + cc * 2; return st * 1024 + (ob ^ (((ob >> 9) & 1) << 5)); }
__host__ __device__ __forceinline__ void stage_rc(int b, int& R, int& C) { const int st = b / 1024, sb = b % 1024, swz = sb ^ (((sb >> 9) & 1) << 5); R = (st >> 1) * 16 + swz / 64; C = (st & 1) * 32 + (swz % 64) / 2; }
__host__ __device__ __forceinline__ int perm32(int rho) { const int n = rho >> 4, i = rho & 15; return 8 * (i >> 2) + 4 * n + (i & 3); }

struct Unit { int pm, pn; };
struct Gemm { const bf16_t* A; const bf16_t* Bt; int M, N, K, lda, ldb, a_pn_off; };

struct StaticOrder {
    int nM, nN, nwg, G, c;
    __host__ __device__ void init(int M, int N, int G_, int c_) { nM = M / BM; nN = N / BM; nwg = nM * nN; G = G_; c = c_; }
    __host__ __device__ bool next(int i, Unit& u) const {
        const long L = (long)i * G + c; if (L >= nwg) return false;
        int wgid = (int)L; { const int q = nwg / NXCD, r = nwg % NXCD, xcd = wgid % NXCD, off = wgid / NXCD; wgid = (xcd < r ? xcd * (q + 1) : r * (q + 1) + (xcd - r) * q) + off; }
        const int nig = WGM * nN, gid = wgid / nig, fm = gid * WGM, gsz = (nM - fm) < WGM ? (nM - fm) : WGM;
        u.pm = fm + ((wgid % nig) % gsz); u.pn = (wgid % nig) / gsz; return true;
    }
    __device__ __forceinline__ void a_ready(const Unit&) const {}
    __device__ __forceinline__ void done(const Unit&) const {}
};

__device__ __forceinline__ unsigned cvt_pk_bf16(float lo, float hi) { unsigned r; asm volatile("v_cvt_pk_bf16_f32 %0, %1, %2" : "=v"(r) : "v"(lo), "v"(hi)); return r; }

struct EpiF32 {
    static constexpr bool PERM = false, AFTER_DRAIN = false;
    float* C; int ldc, pad;
    __device__ __forceinline__ void operator()(const f32x4 (&acc)[2][2][4][2], const Unit& u, int wr, int wc, int fr, int fq) const {
        const int row0 = u.pm * BM + wr * 64 + fr, col0 = u.pn * BM + wc * 32 + 4 * fq;
#pragma unroll
        for (int ai = 0; ai < 2; ++ai)
#pragma unroll
            for (int m = 0; m < 4; ++m) { float* rowp = C + (size_t)(row0 + ai * HALF + m * 16) * ldc + col0;
#pragma unroll
                for (int bj = 0; bj < 2; ++bj)
#pragma unroll
                    for (int n = 0; n < 2; ++n) *(f32x4*)(rowp + bj * HALF + n * 16) = acc[ai][bj][m][n]; }
    }
};
struct EpiBf16 {
    static constexpr bool PERM = true, AFTER_DRAIN = false;
    bf16_t* O; int ldc, pad;
    __device__ __forceinline__ void operator()(const f32x4 (&acc)[2][2][4][2], const Unit& u, int wr, int wc, int fr, int fq) const {
        const int row0 = u.pm * BM + wr * 64 + fr; const int col0 = u.pn * BM + wc * 32 + 8 * fq;
#pragma unroll
        for (int ai = 0; ai < 2; ++ai)
#pragma unroll
            for (int m = 0; m < 4; ++m) { bf16_t* rowp = O + (size_t)(row0 + ai * HALF + m * 16) * ldc + col0;
#pragma unroll
                for (int bj = 0; bj < 2; ++bj) { const f32x4 v0 = acc[ai][bj][m][0], v1 = acc[ai][bj][m][1];
                    u32x4 w; w.x = cvt_pk_bf16(v0[0], v0[1]); w.y = cvt_pk_bf16(v0[2], v0[3]); w.z = cvt_pk_bf16(v1[0], v1[1]); w.w = cvt_pk_bf16(v1[2], v1[3]);
                    *(u32x4*)(rowp + bj * HALF) = w; } }
    }
};
__device__ __forceinline__ float silu_f(float x) { return x * __builtin_amdgcn_rcpf(1.0f + __expf(-x)); }
struct EpiSwiGLU {
    static constexpr bool PERM = true, AFTER_DRAIN = false;
    bf16_t* O; int ldc, pad;
    __device__ __forceinline__ void operator()(const f32x4 (&acc)[2][2][4][2], const Unit& u, int wr, int wc, int fr, int fq) const {
        const int row0 = u.pm * BM + wr * 64 + fr; const int col0 = u.pn * HALF + wc * 32 + 8 * fq;
#pragma unroll
        for (int ai = 0; ai < 2; ++ai)
#pragma unroll
            for (int m = 0; m < 4; ++m) { bf16_t* rowp = O + (size_t)(row0 + ai * HALF + m * 16) * ldc + col0;
                const f32x4 g0 = acc[ai][0][m][0], g1 = acc[ai][0][m][1], u0 = acc[ai][1][m][0], u1 = acc[ai][1][m][1];
                float h[8];
#pragma unroll
                for (int j = 0; j < 4; ++j) { h[j] = silu_f(g0[j]) * u0[j]; h[4 + j] = silu_f(g1[j]) * u1[j]; }
                u32x4 w; w.x = cvt_pk_bf16(h[0], h[1]); w.y = cvt_pk_bf16(h[2], h[3]); w.z = cvt_pk_bf16(h[4], h[5]); w.w = cvt_pk_bf16(h[6], h[7]);
                *(u32x4*)rowp = w; }
    }
};

template <class Epi, class Sched, bool ALIGN_EPI = false, bool SP2 = false>
__device__ __forceinline__ void gemm_phase(PG8_LAS unsigned char* lds, const Gemm g, const Sched& S, const Epi& E) {
    const int tid = threadIdx.x, wid = __builtin_amdgcn_readfirstlane(tid >> 6), lane = tid & 63, wr = wid >> 2, wc = wid & 3, fr = lane & 15, fq = lane >> 4;
    const int K = g.K, nt = K / BK;
    unsigned voffA[2], voffB[2];
#pragma unroll
    for (int i = 0; i < 2; ++i) { int R, C; stage_rc(tid * 16 + i * 8192, R, C); const int Rb = Epi::PERM ? ((R & ~31) + perm32(R & 31)) : R;
        voffA[i] = (unsigned)(R * g.lda + C) * 2u; voffB[i] = (unsigned)(Rb * g.ldb + C) * 2u; }
    const size_t kstep = (size_t)(BK * 2);
    const size_t hstepA = (size_t)HALF * g.lda * 2, hstepB = (size_t)HALF * g.ldb * 2;
    const size_t tstepA = 2 * hstepA, tstepB = 2 * hstepB;
    const size_t pnoffA = (size_t)g.a_pn_off * 2;
    const unsigned ldsw = (unsigned)wid * 1024u;
    const int aoff = lds_byte(wr * 64 + fr, fq * 8), boff = lds_byte(wc * 32 + fr, fq * 8);
#define PG8_SA(b, h) (((b) * 2 + (h)) * HTB)
#define PG8_SB(b, h) ((4 + (b) * 2 + (h)) * HTB)
#define PG8_STAGE(bufoff, gbase, voff) do { _Pragma("unroll") for (int _i = 0; _i < 2; ++_i) \
        __builtin_amdgcn_global_load_lds((const unsigned*)((const char*)(gbase) + (voff)[_i]), (PG8_LAS unsigned*)(lds + (bufoff) + ldsw + _i * 8192), 16, 0, 0); } while (0)
#define PG8_LDA(dst, b, h) do { _Pragma("unroll") for (int m = 0; m < 4; ++m) _Pragma("unroll") for (int k = 0; k < 2; ++k) dst[m][k] = *(const PG8_LAS bf16x8*)(lds + PG8_SA(b, h) + aoff + m * 2048 + k * 1024); } while (0)
#define PG8_LDB(dst, b, h) do { _Pragma("unroll") for (int n = 0; n < 2; ++n) _Pragma("unroll") for (int k = 0; k < 2; ++k) dst[n][k] = *(const PG8_LAS bf16x8*)(lds + PG8_SB(b, h) + boff + n * 2048 + k * 1024); } while (0)
#define PG8_MMA(ai, bj, At, Bt) do { __builtin_amdgcn_s_setprio(1); _Pragma("unroll") for (int m = 0; m < 4; ++m) _Pragma("unroll") for (int n = 0; n < 2; ++n) _Pragma("unroll") for (int k = 0; k < 2; ++k) \
        acc[ai][bj][m][n] = __builtin_amdgcn_mfma_f32_16x16x32_bf16(Bt[n][k], At[m][k], acc[ai][bj][m][n], 0, 0, 0); __builtin_amdgcn_s_setprio(0); } while (0)
#define PG8_WAIT_V(n) asm volatile("s_waitcnt vmcnt(" #n ")" ::: "memory")
#define PG8_WAIT_L(n) asm volatile("s_waitcnt lgkmcnt(" #n ")" ::: "memory")
#define PG8_BAR __builtin_amdgcn_s_barrier()
#define PG8_SCHED __builtin_amdgcn_sched_barrier(0)
    Unit cur, nxt; int ui = 0;
    if (!S.next(0, cur)) return;
    f32x4 acc[2][2][4][2];
#pragma unroll
    for (int a = 0; a < 2; ++a)
#pragma unroll
        for (int b = 0; b < 2; ++b)
#pragma unroll
            for (int m = 0; m < 4; ++m)
#pragma unroll
                for (int n = 0; n < 2; ++n) acc[a][b][m][n] = (f32x4){0.f, 0.f, 0.f, 0.f};
    bf16x8 At[4][2], B0[2][2], B1[2][2];
    const char* cA = (const char*)g.A + (size_t)cur.pm * tstepA + (size_t)cur.pn * pnoffA; const char* cB = (const char*)g.Bt + (size_t)cur.pn * tstepB;
    S.a_ready(cur);
    if constexpr (SP2) {
        PG8_STAGE(PG8_SB(0, 0), cB, voffB); PG8_STAGE(PG8_SB(0, 1), cB + hstepB, voffB); PG8_STAGE(PG8_SA(0, 0), cA, voffA); PG8_STAGE(PG8_SA(0, 1), cA + hstepA, voffA);
        if (wr == 1) PG8_BAR;
        PG8_WAIT_V(2); PG8_BAR;
        PG8_STAGE(PG8_SB(1, 0), cB + kstep, voffB); PG8_STAGE(PG8_SA(1, 0), cA + kstep, voffA); PG8_STAGE(PG8_SB(1, 1), cB + hstepB + kstep, voffB);
        PG8_WAIT_V(6); PG8_BAR;
    } else {
        PG8_STAGE(PG8_SB(0, 0), cB, voffB); PG8_STAGE(PG8_SA(0, 0), cA, voffA); PG8_STAGE(PG8_SB(0, 1), cB + hstepB, voffB); PG8_STAGE(PG8_SA(0, 1), cA + hstepA, voffA);
        if (wr == 1) PG8_BAR;
        PG8_WAIT_V(4); PG8_BAR;
        PG8_STAGE(PG8_SB(1, 0), cB + kstep, voffB); PG8_STAGE(PG8_SA(1, 0), cA + kstep, voffA); PG8_STAGE(PG8_SB(1, 1), cB + hstepB + kstep, voffB);
        PG8_WAIT_V(6); PG8_BAR;
    }
    for (;;) {
        const bool has_next = S.next(ui + 1, nxt);
        const char* nA = has_next ? (const char*)g.A + (size_t)nxt.pm * tstepA + (size_t)nxt.pn * pnoffA : cA; const char* nB = has_next ? (const char*)g.Bt + (size_t)nxt.pn * tstepB : cB;
        for (int t = 0; t < nt; t += 2) {
            const bool last = (t == nt - 2);
            const char* a1 = cA + (size_t)(t + 1) * kstep;
            const char* a2 = last ? nA : cA + (size_t)(t + 2) * kstep; const char* b2 = last ? nB : cB + (size_t)(t + 2) * kstep;
            const char* a3 = a2 + kstep; const char* b3 = b2 + kstep;
            if (last && has_next) S.a_ready(nxt);
            if constexpr (SP2) {
            PG8_LDB(B0, 0, 0); PG8_LDB(B1, 0, 1); PG8_SCHED; PG8_LDA(At, 0, 0); PG8_STAGE(PG8_SA(1, 1), a1 + hstepA, voffA);
            PG8_WAIT_V(8); PG8_WAIT_L(0); PG8_BAR; PG8_MMA(0, 0, At, B0); PG8_MMA(0, 1, At, B1); PG8_BAR; PG8_SCHED;
            PG8_LDA(At, 0, 1); PG8_STAGE(PG8_SB(0, 0), b2, voffB); PG8_STAGE(PG8_SB(0, 1), b2 + hstepB, voffB); PG8_STAGE(PG8_SA(0, 0), a2, voffA);
            PG8_WAIT_V(8); PG8_WAIT_L(0); PG8_BAR; PG8_MMA(1, 0, At, B0); PG8_MMA(1, 1, At, B1); PG8_BAR; PG8_SCHED;
            PG8_LDB(B0, 1, 0); PG8_LDB(B1, 1, 1); PG8_SCHED; PG8_LDA(At, 1, 0); PG8_STAGE(PG8_SA(0, 1), a2 + hstepA, voffA);
            PG8_WAIT_V(8); PG8_WAIT_L(0); PG8_BAR; PG8_MMA(0, 0, At, B0); PG8_MMA(0, 1, At, B1); PG8_BAR; PG8_SCHED;
            PG8_LDA(At, 1, 1); PG8_STAGE(PG8_SB(1, 0), b3, voffB); PG8_STAGE(PG8_SB(1, 1), b3 + hstepB, voffB); PG8_STAGE(PG8_SA(1, 0), a3, voffA);
            PG8_WAIT_V(8); PG8_WAIT_L(0); PG8_BAR; PG8_MMA(1, 0, At, B0); PG8_MMA(1, 1, At, B1); PG8_BAR; PG8_SCHED;
            } else {
            PG8_LDB(B0, 0, 0); PG8_SCHED; PG8_LDA(At, 0, 0); PG8_STAGE(PG8_SA(1, 1), a1 + hstepA, voffA);
            PG8_WAIT_L(8); PG8_BAR; PG8_WAIT_L(0); PG8_MMA(0, 0, At, B0); PG8_BAR; PG8_SCHED;
            PG8_LDB(B1, 0, 1); PG8_STAGE(PG8_SB(0, 0), b2, voffB);
            PG8_BAR; PG8_WAIT_L(0); PG8_MMA(0, 1, At, B1); PG8_BAR;
            PG8_LDA(At, 0, 1); PG8_STAGE(PG8_SA(0, 0), a2, voffA);
            PG8_BAR; PG8_WAIT_L(0); PG8_MMA(1, 0, At, B0); PG8_BAR; PG8_SCHED;
            PG8_STAGE(PG8_SB(0, 1), b2 + hstepB, voffB);
            PG8_WAIT_V(6); PG8_BAR; PG8_MMA(1, 1, At, B1); PG8_BAR;
            PG8_LDB(B0, 1, 0); PG8_SCHED; PG8_LDA(At, 1, 0); PG8_STAGE(PG8_SA(0, 1), a2 + hstepA, voffA);
            PG8_WAIT_L(8); PG8_BAR; PG8_WAIT_L(0); PG8_MMA(0, 0, At, B0); PG8_BAR; PG8_SCHED;
            PG8_LDB(B1, 1, 1); PG8_STAGE(PG8_SB(1, 0), b3, voffB);
            PG8_BAR; PG8_WAIT_L(0); PG8_MMA(0, 1, At, B1); PG8_BAR;
            PG8_LDA(At, 1, 1); PG8_STAGE(PG8_SA(1, 0), a3, voffA);
            PG8_BAR; PG8_WAIT_L(0); PG8_MMA(1, 0, At, B0); PG8_BAR; PG8_SCHED;
            PG8_STAGE(PG8_SB(1, 1), b3 + hstepB, voffB);
            PG8_WAIT_V(6); PG8_BAR; PG8_MMA(1, 1, At, B1); PG8_BAR;
            }
        }
        if constexpr (ALIGN_EPI) { if (wr == 0) PG8_BAR; }
        if constexpr (!Epi::AFTER_DRAIN) { E(acc, cur, wr, wc, fr, fq); S.done(cur); }
        if (!has_next) break;
#pragma unroll
        for (int a = 0; a < 2; ++a)
#pragma unroll
            for (int b = 0; b < 2; ++b)
#pragma unroll
                for (int m = 0; m < 4; ++m)
#pragma unroll
                    for (int n = 0; n < 2; ++n) acc[a][b][m][n] = (f32x4){0.f, 0.f, 0.f, 0.f};
        cur = nxt; cA = nA; cB = nB; ++ui;
        if constexpr (ALIGN_EPI) { if (wr == 1) PG8_BAR; }
    }
    PG8_WAIT_V(0);
    if constexpr (!ALIGN_EPI) { if (wr == 0) PG8_BAR; }
    PG8_BAR;
    if constexpr (Epi::AFTER_DRAIN) { E.fused(acc, cur, wr, wc, fr, fq, lds, wid, lane); S.done(cur); }
#undef PG8_SA
#undef PG8_SB
#undef PG8_STAGE
#undef PG8_LDA
#undef PG8_LDB
#undef PG8_MMA
#undef PG8_WAIT_V
#undef PG8_WAIT_L
#undef PG8_BAR
#undef PG8_SCHED
}
}
namespace cfg {
constexpr int D = 1024, BATCH = 8, SEQ = 2048, MP = BATCH * SEQ, MS = 128, MR = MP + MS, MPAD = 16640;
constexpr int MH = 4, MDK = 256, MDV = 256;
constexpr int SH = 16, SP = 64, SG = 2, SN = 128, CONVD = 1536;
constexpr int INDIM = 6680, NIN = 6912, FF = 2816, NGU = 2 * FF, MIX = 2048;
constexpr float EPS = 1e-6f, GATE_CAP = 15.0f;
constexpr int PQ = 0, PK = 1024, PV = 2048, PO = 3072, PZ = 4096, PX = 5120, PG = 6656;
constexpr int GW = 40;
enum { I_XP = 0, I_XS, I_SC, I_SN, I_SM, I_SSSM, I_SCONV, I_SPOOL, I_GMIXPRE, I_GMIXPOST, I_GFFNPRE, I_GFFNPOST, I_WIN, I_BIG, I_BFG, I_GMLSTM,
       I_CONVW, I_CONVB, I_DTBIAS, I_ALOG, I_DSKIP, I_GSSM, I_WOUT, I_WPOOL, I_POOLSCALE, I_WGATE, I_WUP, I_WDOWN, N_IN };
constexpr size_t O_Y = 0;
constexpr size_t O_CP = O_Y + (size_t)MR * D;
constexpr size_t O_CS = O_CP + (size_t)BATCH * MH * MDK * MDV;
constexpr size_t O_NP = O_CS + (size_t)MS * MH * MDK * MDV;
constexpr size_t O_NS = O_NP + (size_t)BATCH * MH * MDK;
constexpr size_t O_MP = O_NS + (size_t)MS * MH * MDK;
constexpr size_t O_MS = O_MP + (size_t)BATCH * MH;
constexpr size_t O_SSP = O_MS + (size_t)MS * MH;
constexpr size_t O_SSS = O_SSP + (size_t)BATCH * SH * SP * SN;
constexpr size_t O_CVP = O_SSS + (size_t)MS * SH * SP * SN;
constexpr size_t O_CVS = O_CVP + (size_t)BATCH * 3 * CONVD;
constexpr size_t O_PLP = O_CVS + (size_t)MS * 3 * CONVD;
constexpr size_t O_PLS = O_PLP + (size_t)BATCH * 15 * D;
constexpr size_t O_END = O_PLS + (size_t)MS * 15 * D;
static_assert(O_END == 73241120, "output size");
constexpr size_t al(size_t x) { return (x + 4095) & ~(size_t)4095; }
constexpr size_t WS_CTL = 0, CTL_BYTES = 1u << 20;
constexpr size_t WS_WIN = WS_CTL + CTL_BYTES;
constexpr size_t WS_WOUT = WS_WIN + al((size_t)NIN * D * 2);
constexpr size_t WS_WGU = WS_WOUT + al((size_t)D * MIX * 2);
constexpr size_t WS_WDN = WS_WGU + 2 * al((size_t)NGU * D * 2);
constexpr size_t WS_WPOOL = WS_WDN + 2 * al((size_t)D * FF * 2);
constexpr size_t WS_U = WS_WPOOL + al((size_t)D * 256 * 2);
constexpr size_t WS_G = WS_U + al((size_t)MPAD * D * 2);
constexpr size_t WS_XC = WS_G + al((size_t)MR * GW * 4);
constexpr size_t WS_HY = WS_XC + al((size_t)MR * CONVD * 2);
constexpr size_t WS_PROJ = WS_HY + al((size_t)MPAD * MIX * 2);
constexpr size_t WS_OUTF = WS_PROJ;
constexpr size_t WS_HMID = WS_OUTF + al((size_t)MPAD * D * 4);
constexpr size_t WS_U2F = WS_HMID + al((size_t)MPAD * FF * 2);
constexpr size_t WS_END0 = WS_PROJ + al((size_t)MPAD * NIN * 2);
constexpr size_t WS_END1 = WS_U2F + al((size_t)MR * D * 4);
constexpr size_t WS_END = WS_END0 > WS_END1 ? WS_END0 : WS_END1;
}

typedef unsigned short bf16;
#define LAS __attribute__((address_space(3)))
typedef float f32x4 __attribute__((ext_vector_type(4)));
typedef unsigned u32x4 __attribute__((ext_vector_type(4)));
typedef unsigned u32x2 __attribute__((ext_vector_type(2)));

__device__ __forceinline__ unsigned f2bf(float f) { unsigned u = __builtin_bit_cast(unsigned, f); return (u + 0x7fffu + ((u >> 16) & 1u)) >> 16; }
__device__ __forceinline__ unsigned pk2(float lo, float hi) { return f2bf(lo) | (f2bf(hi) << 16); }
__device__ __forceinline__ float bf2f(unsigned short b) { return __builtin_bit_cast(float, (unsigned)b << 16); }
__device__ __forceinline__ float bflo(unsigned w) { return __builtin_bit_cast(float, w << 16); }
__device__ __forceinline__ float bfhi(unsigned w) { return __builtin_bit_cast(float, w & 0xffff0000u); }
__device__ __forceinline__ f32x4 ld_bf4(const bf16* p) { const u32x2 w = *(const u32x2*)p; return (f32x4){bflo(w.x), bfhi(w.x), bflo(w.y), bfhi(w.y)}; }
__device__ __forceinline__ void st_bf4(bf16* p, f32x4 v) { u32x2 w; w.x = pk2(v.x, v.y); w.y = pk2(v.z, v.w); *(u32x2*)p = w; }
__device__ __forceinline__ float wave_sum(float v) {
#pragma unroll
    for (int o = 1; o < 64; o <<= 1) v += __shfl_xor(v, o);
    return v;
}
__device__ __forceinline__ float sigmoid_f(float x) { return 1.0f / (1.0f + expf(-x)); }
__device__ __forceinline__ float silu_x(float x) { return x / (1.0f + expf(-x)); }
__device__ __forceinline__ float softplus_f(float x) { return fmaxf(x, 0.f) + log1pf(expf(-fabsf(x))); }
__device__ __forceinline__ float softcap_f(float x) { return cfg::GATE_CAP * tanhf(x * (1.0f / cfg::GATE_CAP)); }
using namespace cfg;

struct PrepMat { const float* W0; const float* W1; const float* scale; bf16* WT; int ldw, K, N, mode, nitems, pad; };
__device__ __forceinline__ void prep_item(const PrepMat& P, int item, LAS float* scr, int lane) {
    const int nblk = P.N / 32, kb = item / nblk, nb = item % nblk, k0 = 64 * kb, n0 = 32 * nb;
    const int n = n0 + (lane & 31);
    const float* W = P.W0; int sc = n; float mul = 1.0f;
    if (P.mode == 1) {
        if (n < 4096) { sc = n; if (n < 1024) mul = 0.0625f; }
        else if (n < 5120) sc = 4104 + (n - 4096);
        else if (n < 6656) sc = 5128 + (n - 5120);
        else if (n < 6664) sc = 4096 + (n - 6656);
        else if (n < 6680) sc = n;
        else sc = -1;
    } else if (P.mode == 2) {
        const int pn = n >> 8, w = n & 255; W = (w < 128) ? P.W0 : P.W1; sc = 128 * pn + (w & 127);
    } else if (P.mode == 3) {
        mul = P.scale[n];
    }
#pragma unroll 8
    for (int i = 0; i < 32; ++i) { const int kk = 2 * i + (lane >> 5); scr[kk * 33 + (lane & 31)] = (sc >= 0) ? W[(size_t)(k0 + kk) * P.ldw + sc] * mul : 0.f; }
    asm volatile("s_waitcnt lgkmcnt(0)" ::: "memory");
    const int c = lane & 7;
#pragma unroll
    for (int j = 0; j < 4; ++j) { const int nn = (lane >> 3) + 8 * j; const LAS float* s = scr + (8 * c) * 33 + nn;
        u32x4 o; o.x = pk2(s[0 * 33], s[1 * 33]); o.y = pk2(s[2 * 33], s[3 * 33]); o.z = pk2(s[4 * 33], s[5 * 33]); o.w = pk2(s[6 * 33], s[7 * 33]);
        *(u32x4*)(P.WT + (size_t)(n0 + nn) * P.K + k0 + 8 * c) = o; }
    asm volatile("s_waitcnt lgkmcnt(0)" ::: "memory");
}
struct PrepArgs { PrepMat m[10]; int nmat; int pad; };
__global__ void __launch_bounds__(256) k_prep(PrepArgs a) {
    __shared__ float scr_all[4][64 * 33];
    const int wave = threadIdx.x >> 6, lane = threadIdx.x & 63;
    LAS float* scr = (LAS float*)&scr_all[wave][0];
    const int gw = blockIdx.x * 4 + wave, ngw = gridDim.x * 4;
    int total = 0;
    for (int i = 0; i < a.nmat; ++i) total += a.m[i].nitems;
    for (int it = gw; it < total; it += ngw) {
        int r = it, mi = 0;
        while (r >= a.m[mi].nitems) { r -= a.m[mi].nitems; ++mi; }
        prep_item(a.m[mi], r, scr, lane);
    }
}

__device__ __forceinline__ const float* x_row(const float* xp, const float* xs, int r) { return r < MP ? xp + (size_t)r * D : xs + (size_t)(r - MP) * D; }

__global__ void __launch_bounds__(256) k_norm0(const float* xp, const float* xs, const float* g, bf16* U) {
    const int lane = threadIdx.x & 63, gw = blockIdx.x * 4 + (threadIdx.x >> 6), ngw = gridDim.x * 4;
    for (int r = gw; r < MPAD; r += ngw) {
        bf16* o = U + (size_t)r * D;
        if (r >= MR) {
#pragma unroll
            for (int j = 0; j < 4; ++j) *(u32x2*)(o + 4 * lane + 256 * j) = (u32x2){0u, 0u};
            continue; }
        const float* x = x_row(xp, xs, r);
        f32x4 v[4]; float ss = 0.f;
#pragma unroll
        for (int j = 0; j < 4; ++j) { v[j] = *(const f32x4*)(x + 4 * lane + 256 * j); ss += v[j].x * v[j].x + v[j].y * v[j].y + v[j].z * v[j].z + v[j].w * v[j].w; }
        const float rstd = 1.0f / sqrtf(wave_sum(ss) * (1.0f / D) + EPS);
#pragma unroll
        for (int j = 0; j < 4; ++j) { const f32x4 gg = *(const f32x4*)(g + 4 * lane + 256 * j); st_bf4(o + 4 * lane + 256 * j, v[j] * rstd * gg); }
    }
}

__global__ void __launch_bounds__(256) k_conv(const bf16* proj, const float* sconv, const float* cw, const float* cb, const float* big, const float* bfg,
                                              const float* dtb, const float* alog, bf16* XC, float* G, float* out) {
    const size_t nthr = (size_t)gridDim.x * blockDim.x, t0 = (size_t)blockIdx.x * blockDim.x + threadIdx.x;
    for (size_t i = t0; i < (size_t)MR * (CONVD / 4); i += nthr) {
        const int r = (int)(i / (CONVD / 4)), c = 4 * (int)(i % (CONVD / 4));
        f32x4 acc = *(const f32x4*)(cb + c);
#pragma unroll
        for (int j = 0; j < 4; ++j) {
            f32x4 xv;
            if (r < MP) { const int t = r & (SEQ - 1); if (t - 3 + j < 0) continue; xv = ld_bf4(proj + (size_t)(r - 3 + j) * NIN + PX + c); }
            else { const int b = r - MP; if (j < 3) xv = *(const f32x4*)(sconv + ((size_t)b * 3 + j) * CONVD + c); else xv = ld_bf4(proj + (size_t)r * NIN + PX + c); }
            acc += xv * *(const f32x4*)(cw + (size_t)j * CONVD + c);
        }
        f32x4 y; y.x = silu_x(acc.x); y.y = silu_x(acc.y); y.z = silu_x(acc.z); y.w = silu_x(acc.w);
        st_bf4(XC + (size_t)r * CONVD + c, y);
    }
    for (size_t i = t0; i < (size_t)BATCH * 3 * (CONVD / 4); i += nthr) {
        const int c = 4 * (int)(i % (CONVD / 4)), j = (int)(i / (CONVD / 4)) % 3, b = (int)(i / (CONVD / 4)) / 3;
        *(f32x4*)(out + O_CVP + ((size_t)b * 3 + j) * CONVD + c) = ld_bf4(proj + (size_t)(b * SEQ + SEQ - 3 + j) * NIN + PX + c);
    }
    for (size_t i = t0; i < (size_t)MS * 3 * (CONVD / 4); i += nthr) {
        const int c = 4 * (int)(i % (CONVD / 4)), j = (int)(i / (CONVD / 4)) % 3, b = (int)(i / (CONVD / 4)) / 3;
        f32x4 v; if (j < 2) v = *(const f32x4*)(sconv + ((size_t)b * 3 + j + 1) * CONVD + c); else v = ld_bf4(proj + (size_t)(MP + b) * NIN + PX + c);
        *(f32x4*)(out + O_CVS + ((size_t)b * 3 + j) * CONVD + c) = v;
    }
    for (size_t i = t0; i < (size_t)MR * 24; i += nthr) {
        const int r = (int)(i / 24), k = (int)(i % 24);
        const float pre = bf2f(proj[(size_t)r * NIN + PG + k]);
        float* g = G + (size_t)r * GW;
        if (k < 4) g[k] = softcap_f(pre + big[k]);
        else if (k < 8) { const float x = softcap_f(pre + bfg[k - 4]); g[k] = fminf(x, 0.f) - log1pf(expf(-fabsf(x))); }
        else { const int hd = k - 8; const float dt = softplus_f(pre + dtb[hd]); g[8 + hd] = dt; g[24 + hd] = -dt * expf(alog[hd]); }
    }
}

__global__ void __launch_bounds__(256) k_mlstm_prompt(const bf16* proj, const float* G, bf16* HY, float* out) {
    const int vs = blockIdx.x & 7, h = (blockIdx.x >> 3) & 3, b = blockIdx.x >> 5;
    const int tid = threadIdx.x, dg = tid >> 5, vv = tid & 31, lane = tid & 63, wave = tid >> 6;
    __shared__ float qs[16][256], ks[16][256], vsh[16][32], pnum[16][8][32], pqn[16][4], mts[16], decs[16], wsh[16], lis[16], lfs[16];
    float c[32];
#pragma unroll
    for (int i = 0; i < 32; ++i) c[i] = 0.f;
    float nd = 0.f;
    __shared__ float m_carry;
    if (tid == 0) m_carry = 0.f;
    for (int t0 = 0; t0 < SEQ; t0 += 16) {
        __syncthreads();
        const size_t row0 = (size_t)b * SEQ + t0;
        for (int tt = 0; tt < 16; ++tt) {
            qs[tt][tid] = bf2f(proj[(row0 + tt) * NIN + PQ + h * 256 + tid]);
            ks[tt][tid] = bf2f(proj[(row0 + tt) * NIN + PK + h * 256 + tid]);
        }
        for (int e = tid; e < 16 * 32; e += 256) { const int tt = e >> 5, v = e & 31; vsh[tt][v] = bf2f(proj[(row0 + tt) * NIN + PV + h * 256 + vs * 32 + v]); }
        if (tid < 16) { lis[tid] = G[(row0 + tid) * GW + h]; lfs[tid] = G[(row0 + tid) * GW + 4 + h]; }
        __syncthreads();
        if (tid == 0) {
            float m = m_carry;
            for (int tt = 0; tt < 16; ++tt) { const float li = lis[tt], lf = lfs[tt]; const float mn = fmaxf(lf + m, li); decs[tt] = expf(lf + m - mn); wsh[tt] = expf(li - mn); mts[tt] = mn; m = mn; }
            m_carry = m;
        }
        __syncthreads();
        for (int tt = 0; tt < 16; ++tt) {
            const float dec = decs[tt], w = wsh[tt];
            const float vval = vsh[tt][vv] * w;
            float acc = 0.f;
#pragma unroll
            for (int i = 0; i < 32; ++i) { c[i] = dec * c[i] + ks[tt][dg * 32 + i] * vval; acc += qs[tt][dg * 32 + i] * c[i]; }
            pnum[tt][dg][vv] = acc;
            nd = dec * nd + w * ks[tt][tid];
            const float qn = wave_sum(qs[tt][tid] * nd);
            if (lane == 0) pqn[tt][wave] = qn;
        }
        __syncthreads();
#pragma unroll
        for (int rep = 0; rep < 2; ++rep) {
            const int tt = (tid >> 5) + 8 * rep;
            float num = 0.f;
#pragma unroll
            for (int g8 = 0; g8 < 8; ++g8) num += pnum[tt][g8][vv];
            const float den = (pqn[tt][0] + pqn[tt][1]) + (pqn[tt][2] + pqn[tt][3]);
            const float hval = num / fmaxf(fabsf(den), expf(-mts[tt]));
            HY[(row0 + tt) * MIX + h * 256 + vs * 32 + vv] = (bf16)f2bf(hval);
        }
    }
    __syncthreads();
#pragma unroll
    for (int i = 0; i < 32; ++i) out[O_CP + ((size_t)(b * MH + h) * MDK + dg * 32 + i) * MDV + vs * 32 + vv] = c[i];
    if (vs == 0) { out[O_NP + (size_t)(b * MH + h) * MDK + tid] = nd; if (tid == 0) out[O_MP + b * MH + h] = m_carry; }
}

__global__ void __launch_bounds__(256) k_mlstm_sample(const bf16* proj, const float* G, const float* cin, const float* nin, const float* min_, bf16* HY, float* out) {
    const int h = blockIdx.x & 3, b = blockIdx.x >> 2, tid = threadIdx.x, lane = tid & 63, wave = tid >> 6;
    const size_t row = (size_t)MP + b;
    __shared__ float qs[256], ks[256], red[4][256], qnr[4];
    qs[tid] = bf2f(proj[row * NIN + PQ + h * 256 + tid]); ks[tid] = bf2f(proj[row * NIN + PK + h * 256 + tid]);
    const float li = G[row * GW + h], lf = G[row * GW + 4 + h], m = min_[b * MH + h];
    const float mn = fmaxf(lf + m, li), dec = expf(lf + m - mn), w = expf(li - mn);
    __syncthreads();
    const float nd = dec * nin[(size_t)(b * MH + h) * MDK + tid] + w * ks[tid];
    out[O_NS + (size_t)(b * MH + h) * MDK + tid] = nd;
    const float qn = wave_sum(qs[tid] * nd);
    if (lane == 0) qnr[wave] = qn;
    const int dq = tid >> 6, v4 = tid & 63;
    const f32x4 vv = ld_bf4(proj + row * NIN + PV + h * 256 + 4 * v4) * w;
    f32x4 acc = (f32x4){0.f, 0.f, 0.f, 0.f};
    const float* cbase = cin + ((size_t)(b * MH + h) * MDK) * MDV + 4 * v4;
    float* obase = out + O_CS + ((size_t)(b * MH + h) * MDK) * MDV + 4 * v4;
    for (int d = dq * 64; d < dq * 64 + 64; ++d) {
        const f32x4 c4 = *(const f32x4*)(cbase + (size_t)d * MDV);
        const f32x4 cn = c4 * dec + vv * ks[d];
        *(f32x4*)(obase + (size_t)d * MDV) = cn;
        acc += cn * qs[d];
    }
    red[dq][4 * v4 + 0] = acc.x; red[dq][4 * v4 + 1] = acc.y; red[dq][4 * v4 + 2] = acc.z; red[dq][4 * v4 + 3] = acc.w;
    __syncthreads();
    const float num = (red[0][tid] + red[1][tid]) + (red[2][tid] + red[3][tid]);
    const float den = (qnr[0] + qnr[1]) + (qnr[2] + qnr[3]);
    HY[row * MIX + h * 256 + tid] = (bf16)f2bf(num / fmaxf(fabsf(den), expf(-mn)));
    if (tid == 0) out[O_MS + b * MH + h] = mn;
}

__global__ void __launch_bounds__(256) k_ssd_prompt(const bf16* XC, const float* G, const float* dskip, bf16* HY, float* out) {
    const int head = blockIdx.x & 15, b = blockIdx.x >> 4, g = head >> 3;
    const int tid = threadIdx.x, p = tid >> 2, nq = tid & 3;
    __shared__ float xs[16][64], Bs[16][4][36], Cs[16][4][36], dts[16], as_[16];
    float hst[32];
#pragma unroll
    for (int i = 0; i < 32; ++i) hst[i] = 0.f;
    const float dsk = dskip[head];
    for (int t0 = 0; t0 < SEQ; t0 += 16) {
        __syncthreads();
        const size_t row0 = (size_t)b * SEQ + t0;
        for (int e = tid; e < 16 * 64; e += 256) { const int tt = e >> 6, pp = e & 63; xs[tt][pp] = bf2f(XC[(row0 + tt) * CONVD + head * 64 + pp]); }
        for (int e = tid; e < 16 * 128; e += 256) { const int tt = e >> 7, n = e & 127;
            Bs[tt][n >> 5][n & 31] = bf2f(XC[(row0 + tt) * CONVD + 1024 + g * 128 + n]);
            Cs[tt][n >> 5][n & 31] = bf2f(XC[(row0 + tt) * CONVD + 1280 + g * 128 + n]); }
        if (tid < 16) { dts[tid] = G[(row0 + tid) * GW + 8 + head]; as_[tid] = G[(row0 + tid) * GW + 24 + head]; }
        __syncthreads();
        for (int tt = 0; tt < 16; ++tt) {
            const float decay = expf(as_[tt]), xv = xs[tt][p], coef = dts[tt] * xv;
            float acc = 0.f;
#pragma unroll
            for (int i = 0; i < 32; ++i) { hst[i] = decay * hst[i] + coef * Bs[tt][nq][i]; acc += Cs[tt][nq][i] * hst[i]; }
            acc += __shfl_xor(acc, 1); acc += __shfl_xor(acc, 2);
            if (nq == 0) HY[(row0 + tt) * MIX + 1024 + head * 64 + p] = (bf16)f2bf(acc + dsk * xv);
        }
    }
#pragma unroll
    for (int i = 0; i < 32; ++i) out[O_SSP + ((size_t)(b * SH + head) * SP + p) * SN + nq * 32 + i] = hst[i];
}

__global__ void __launch_bounds__(256) k_ssd_sample(const bf16* XC, const float* G, const float* dskip, const float* sin_, bf16* HY, float* out) {
    const int head = blockIdx.x & 15, b = blockIdx.x >> 4, g = head >> 3;
    const int tid = threadIdx.x, pj = tid >> 5, n4 = tid & 31;
    const size_t row = (size_t)MP + b;
    const float dt = G[row * GW + 8 + head], decay = expf(G[row * GW + 24 + head]), dsk = dskip[head];
    const f32x4 B4 = ld_bf4(XC + row * CONVD + 1024 + g * 128 + 4 * n4), C4 = ld_bf4(XC + row * CONVD + 1280 + g * 128 + 4 * n4);
#pragma unroll
    for (int j = 0; j < 8; ++j) {
        const int p = pj + 8 * j;
        const float xv = bf2f(XC[row * CONVD + head * 64 + p]);
        const size_t off = ((size_t)(b * SH + head) * SP + p) * SN + 4 * n4;
        const f32x4 hn = *(const f32x4*)(sin_ + off) * decay + B4 * (dt * xv);
        *(f32x4*)(out + O_SSS + off) = hn;
        float acc = C4.x * hn.x + C4.y * hn.y + C4.z * hn.z + C4.w * hn.w;
#pragma unroll
        for (int o = 1; o < 32; o <<= 1) acc += __shfl_xor(acc, o);
        if (n4 == 0) HY[row * MIX + 1024 + head * 64 + p] = (bf16)f2bf(acc + dsk * xv);
    }
}

__global__ void __launch_bounds__(256) k_finish(const bf16* proj, const float* gml, const float* gssm, bf16* HY) {
    const int lane = threadIdx.x & 63, gw = blockIdx.x * 4 + (threadIdx.x >> 6), ngw = gridDim.x * 4;
    for (int r = gw; r < MPAD; r += ngw) {
        bf16* hy = HY + (size_t)r * MIX;
        if (r >= MR) {
#pragma unroll
            for (int j = 0; j < 8; ++j) *(u32x2*)(hy + 4 * lane + 256 * j) = (u32x2){0u, 0u};
            continue; }
        const bf16* pr = proj + (size_t)r * NIN;
        f32x4 v[8]; float ss[8];
#pragma unroll
        for (int j = 0; j < 8; ++j) {
            v[j] = ld_bf4(hy + 4 * lane + 256 * j);
            if (j >= 4) { const f32x4 z = ld_bf4(pr + PZ + 4 * lane + 256 * (j - 4)); v[j].x *= silu_x(z.x); v[j].y *= silu_x(z.y); v[j].z *= silu_x(z.z); v[j].w *= silu_x(z.w); }
            ss[j] = wave_sum(v[j].x * v[j].x + v[j].y * v[j].y + v[j].z * v[j].z + v[j].w * v[j].w);
        }
#pragma unroll
        for (int j = 0; j < 8; ++j) {
            const int col = 4 * lane + 256 * j;
            f32x4 o;
            if (j < 4) {
                const float rstd = 1.0f / sqrtf(ss[j] * (1.0f / 256.0f) + EPS);
                const f32x4 gg = *(const f32x4*)(gml + col), og = ld_bf4(pr + PO + col);
                o = v[j] * rstd * gg; o.x *= sigmoid_f(og.x); o.y *= sigmoid_f(og.y); o.z *= sigmoid_f(og.z); o.w *= sigmoid_f(og.w);
            } else {
                const int j0 = 4 + ((j - 4) & ~1);
                const float rstd = 1.0f / sqrtf((ss[j0] + ss[j0 + 1]) * (1.0f / 512.0f) + EPS);
                o = v[j] * rstd * *(const f32x4*)(gssm + col - 1024);
            }
            st_bf4(hy + col, o);
        }
    }
}

__global__ void __launch_bounds__(256) k_rowpass(const float* xp, const float* xs, const float* xin, const float* outf, const float* gpost, const float* gnext,
                                                 float* xout, bf16* UB, float* UF) {
    const int lane = threadIdx.x & 63, gw = blockIdx.x * 4 + (threadIdx.x >> 6), ngw = gridDim.x * 4;
    for (int r = gw; r < MPAD; r += ngw) {
        if (r >= MR) {
            if (UB) {
#pragma unroll
                for (int j = 0; j < 4; ++j) *(u32x2*)(UB + (size_t)r * D + 4 * lane + 256 * j) = (u32x2){0u, 0u}; }
            continue; }
        const float* xi = xin ? xin + (size_t)r * D : x_row(xp, xs, r);
        f32x4 o[4], x[4]; float ss = 0.f;
#pragma unroll
        for (int j = 0; j < 4; ++j) { o[j] = *(const f32x4*)(outf + (size_t)r * D + 4 * lane + 256 * j); x[j] = *(const f32x4*)(xi + 4 * lane + 256 * j);
            ss += o[j].x * o[j].x + o[j].y * o[j].y + o[j].z * o[j].z + o[j].w * o[j].w; }
        const float rstd = 1.0f / sqrtf(wave_sum(ss) * (1.0f / D) + EPS);
        float ss2 = 0.f;
#pragma unroll
        for (int j = 0; j < 4; ++j) { x[j] += o[j] * rstd * *(const f32x4*)(gpost + 4 * lane + 256 * j); *(f32x4*)(xout + (size_t)r * D + 4 * lane + 256 * j) = x[j];
            ss2 += x[j].x * x[j].x + x[j].y * x[j].y + x[j].z * x[j].z + x[j].w * x[j].w; }
        if (gnext) {
            const float rstd2 = 1.0f / sqrtf(wave_sum(ss2) * (1.0f / D) + EPS);
#pragma unroll
            for (int j = 0; j < 4; ++j) { const f32x4 u = x[j] * rstd2 * *(const f32x4*)(gnext + 4 * lane + 256 * j);
                if (UB) st_bf4(UB + (size_t)r * D + 4 * lane + 256 * j, u);
                if (UF) *(f32x4*)(UF + (size_t)r * D + 4 * lane + 256 * j) = u; }
        }
    }
}

__global__ void __launch_bounds__(256) k_pool(const float* U2F, const float* spool, bf16* DP, float* out) {
    const size_t nthr = (size_t)gridDim.x * blockDim.x, t0 = (size_t)blockIdx.x * blockDim.x + threadIdx.x;
    for (size_t i = t0; i < (size_t)MPAD * (D / 4); i += nthr) {
        const int r = (int)(i / (D / 4)), c = 4 * (int)(i % (D / 4));
        if (r >= MR) { *(u32x2*)(DP + (size_t)r * D + c) = (u32x2){0u, 0u}; continue; }
        const int w = 2 << (c >> 8);
        const f32x4 u = *(const f32x4*)(U2F + (size_t)r * D + c);
        f32x4 s = u; float cnt;
        if (r < MP) { const int t = r & (SEQ - 1); const int n = (t + 1 < w) ? t + 1 : w; cnt = (float)n;
            for (int k = 1; k < n; ++k) s += *(const f32x4*)(U2F + (size_t)(r - k) * D + c); }
        else { const int b = r - MP; cnt = (float)w;
            for (int k = 1; k < w; ++k) s += *(const f32x4*)(spool + ((size_t)b * 15 + 15 - k) * D + c); }
        st_bf4(DP + (size_t)r * D + c, s / cnt - u);
    }
    for (size_t i = t0; i < (size_t)BATCH * 15 * (D / 4); i += nthr) {
        const int c = 4 * (int)(i % (D / 4)), j = (int)(i / (D / 4)) % 15, b = (int)(i / (D / 4)) / 15;
        *(f32x4*)(out + O_PLP + ((size_t)b * 15 + j) * D + c) = *(const f32x4*)(U2F + (size_t)(b * SEQ + SEQ - 15 + j) * D + c);
    }
    for (size_t i = t0; i < (size_t)MS * 15 * (D / 4); i += nthr) {
        const int c = 4 * (int)(i % (D / 4)), j = (int)(i / (D / 4)) % 15, b = (int)(i / (D / 4)) / 15;
        f32x4 v; if (j < 14) v = *(const f32x4*)(spool + ((size_t)b * 15 + j + 1) * D + c); else v = *(const f32x4*)(U2F + (size_t)(MP + b) * D + c);
        *(f32x4*)(out + O_PLS + ((size_t)b * 15 + j) * D + c) = v;
    }
}
template <class Epi> __global__ void __launch_bounds__(512, 2) k_gemm(pg8::Gemm g, Epi E) {
    extern __shared__ __attribute__((aligned(16))) unsigned char lds_dyn[];
    pg8::StaticOrder S; S.init(g.M, g.N, (int)gridDim.x, (int)blockIdx.x);
    pg8::gemm_phase<Epi, pg8::StaticOrder, true, true>((PG8_LAS unsigned char*)lds_dyn, g, S, E);
}
template <class Epi> static void launch_gemm(const pg8::Gemm& g, const Epi& E, hipStream_t stream) {
    static bool attr_done = false;
    if (!attr_done) { (void)hipFuncSetAttribute((const void*)k_gemm<Epi>, hipFuncAttributeMaxDynamicSharedMemorySize, pg8::STAGE_BYTES); attr_done = true; }
    hipLaunchKernelGGL((k_gemm<Epi>), dim3(256), dim3(512), pg8::STAGE_BYTES, stream, g, E);
}
static void set_mat(PrepMat& m, const float* W0, const float* W1, const float* scale, int ldw, int K, int N, int mode, bf16* WT) {
    m.W0 = W0; m.W1 = W1; m.scale = scale; m.WT = WT; m.ldw = ldw; m.K = K; m.N = N; m.mode = mode; m.nitems = (K / 64) * (N / 32); m.pad = 0;
}

extern "C" void kernel_launch(void* const* d_in, const int* in_sizes, int n_in, void* d_out, int out_size, void* d_ws, size_t ws_size, hipStream_t stream) {
    using namespace cfg;
    if (n_in != N_IN || (size_t)out_size != O_END || ws_size < WS_END) {
        fprintf(stderr, "kernel_launch: unexpected sizes n_in %d out %d ws %zu (need %zu)\n", n_in, out_size, ws_size, (size_t)WS_END); return; }
    const float* in[N_IN]; for (int i = 0; i < N_IN; ++i) in[i] = (const float*)d_in[i];
    float* out = (float*)d_out; unsigned char* ws = (unsigned char*)d_ws;
    bf16* WIN = (bf16*)(ws + WS_WIN); bf16* WOUT = (bf16*)(ws + WS_WOUT); bf16* WPOOL = (bf16*)(ws + WS_WPOOL);
    bf16* WGU[2] = {(bf16*)(ws + WS_WGU), (bf16*)(ws + WS_WGU + al((size_t)NGU * D * 2))};
    bf16* WDN[2] = {(bf16*)(ws + WS_WDN), (bf16*)(ws + WS_WDN + al((size_t)D * FF * 2))};
    bf16* U = (bf16*)(ws + WS_U); float* G = (float*)(ws + WS_G); bf16* XC = (bf16*)(ws + WS_XC); bf16* HY = (bf16*)(ws + WS_HY);
    bf16* PROJ = (bf16*)(ws + WS_PROJ); float* OUTF = (float*)(ws + WS_OUTF); bf16* HMID = (bf16*)(ws + WS_HMID); float* U2F = (float*)(ws + WS_U2F);

    PrepArgs pa; memset(&pa, 0, sizeof(pa));
    set_mat(pa.m[0], in[I_WIN], nullptr, nullptr, INDIM, D, NIN, 1, WIN);
    set_mat(pa.m[1], in[I_WOUT], nullptr, nullptr, D, MIX, D, 0, WOUT);
    for (int l = 0; l < 2; ++l) {
        set_mat(pa.m[2 + l], in[I_WGATE] + (size_t)l * D * FF, in[I_WUP] + (size_t)l * D * FF, nullptr, FF, D, NGU, 2, WGU[l]);
        set_mat(pa.m[4 + l], in[I_WDOWN] + (size_t)l * FF * D, nullptr, nullptr, D, FF, D, 0, WDN[l]);
    }
    for (int g = 0; g < 4; ++g) set_mat(pa.m[6 + g], in[I_WPOOL] + (size_t)g * 65536, nullptr, in[I_POOLSCALE] + g * 256, 256, 256, 256, 3, WPOOL + (size_t)g * 65536);
    pa.nmat = 10;
    hipLaunchKernelGGL(k_prep, dim3(1024), dim3(256), 0, stream, pa);
    hipLaunchKernelGGL(k_norm0, dim3(1024), dim3(256), 0, stream, in[I_XP], in[I_XS], in[I_GMIXPRE], U);
    launch_gemm(pg8::Gemm{U, WIN, MPAD, NIN, D, D, D, 0}, pg8::EpiBf16{PROJ, NIN, 0}, stream);
    hipLaunchKernelGGL(k_conv, dim3(2048), dim3(256), 0, stream, (const bf16*)PROJ, in[I_SCONV], in[I_CONVW], in[I_CONVB], in[I_BIG], in[I_BFG], in[I_DTBIAS], in[I_ALOG], XC, G, out);
    hipLaunchKernelGGL(k_mlstm_prompt, dim3(BATCH * MH * 8), dim3(256), 0, stream, (const bf16*)PROJ, (const float*)G, HY, out);
    hipLaunchKernelGGL(k_ssd_prompt, dim3(BATCH * SH), dim3(256), 0, stream, (const bf16*)XC, (const float*)G, in[I_DSKIP], HY, out);
    hipLaunchKernelGGL(k_mlstm_sample, dim3(MS * MH), dim3(256), 0, stream, (const bf16*)PROJ, (const float*)G, in[I_SC], in[I_SN], in[I_SM], HY, out);
    hipLaunchKernelGGL(k_ssd_sample, dim3(MS * SH), dim3(256), 0, stream, (const bf16*)XC, (const float*)G, in[I_DSKIP], in[I_SSSM], HY, out);
    hipLaunchKernelGGL(k_finish, dim3(1024), dim3(256), 0, stream, (const bf16*)PROJ, in[I_GMLSTM], in[I_GSSM], HY);
    launch_gemm(pg8::Gemm{HY, WOUT, MPAD, D, MIX, MIX, MIX, 0}, pg8::EpiF32{OUTF, D, 0}, stream);
    hipLaunchKernelGGL(k_rowpass, dim3(1024), dim3(256), 0, stream, in[I_XP], in[I_XS], (const float*)nullptr, (const float*)OUTF, in[I_GMIXPOST], in[I_GFFNPRE], out + O_Y, U, (float*)nullptr);
    launch_gemm(pg8::Gemm{U, WGU[0], MPAD, NGU, D, D, D, 0}, pg8::EpiSwiGLU{HMID, FF, 0}, stream);
    launch_gemm(pg8::Gemm{HMID, WDN[0], MPAD, D, FF, FF, FF, 0}, pg8::EpiF32{OUTF, D, 0}, stream);
    hipLaunchKernelGGL(k_rowpass, dim3(1024), dim3(256), 0, stream, in[I_XP], in[I_XS], (const float*)(out + O_Y), (const float*)OUTF, in[I_GFFNPOST], in[I_GMIXPRE] + D, out + O_Y, (bf16*)nullptr, U2F);
    hipLaunchKernelGGL(k_pool, dim3(2048), dim3(256), 0, stream, (const float*)U2F, in[I_SPOOL], U, out);
    launch_gemm(pg8::Gemm{U, WPOOL, MPAD, D, 256, D, 256, 256}, pg8::EpiF32{OUTF, D, 0}, stream);
    hipLaunchKernelGGL(k_rowpass, dim3(1024), dim3(256), 0, stream, in[I_XP], in[I_XS], (const float*)(out + O_Y), (const float*)OUTF, in[I_GMIXPOST] + D, in[I_GFFNPRE] + D, out + O_Y, U, (float*)nullptr);
    launch_gemm(pg8::Gemm{U, WGU[1], MPAD, NGU, D, D, D, 0}, pg8::EpiSwiGLU{HMID, FF, 0}, stream);
    launch_gemm(pg8::Gemm{HMID, WDN[1], MPAD, D, FF, FF, FF, 0}, pg8::EpiF32{OUTF, D, 0}, stream);
    hipLaunchKernelGGL(k_rowpass, dim3(1024), dim3(256), 0, stream, in[I_XP], in[I_XS], (const float*)(out + O_Y), (const float*)OUTF, in[I_GFFNPOST] + D, (const float*)nullptr, out + O_Y, (bf16*)nullptr, (float*)nullptr);
}
```

```cpp
#include <hip/hip_runtime.h>
#include <cstdio>
#include <cstring>
#include <cstdint>
namespace pg8 {
#define PG8_LAS __attribute__((address_space(3)))
typedef unsigned short bf16_t;
typedef short bf16x8 __attribute__((ext_vector_type(8)));
typedef float f32x4 __attribute__((ext_vector_type(4)));
typedef float f32x2 __attribute__((ext_vector_type(2)));
typedef unsigned u32x4 __attribute__((ext_vector_type(4)));
constexpr int BM = 256, BK = 64, HALF = 128, HTB = HALF * BK * 2  , STAGE_BYTES = 8 * HTB, NXCD = 8, WGM = 8;

__host__ __device__ __forceinline__ int lds_byte(int r, int c) { const int st = (r >> 4) * 2 + (c >> 5), rr = r & 15, cc = c & 31, ob = rr * 64 + cc * 2; return st * 1024 + (ob ^ (((ob >> 9) & 1) << 5)); }
__host__ __device__ __forceinline__ void stage_rc(int b, int& R, int& C) { const int st = b / 1024, sb = b % 1024, swz = sb ^ (((sb >> 9) & 1) << 5); R = (st >> 1) * 16 + swz / 64; C = (st & 1) * 32 + (swz % 64) / 2; }
__host__ __device__ __forceinline__ int perm32(int rho) { const int n = rho >> 4, i = rho & 15; return 8 * (i >> 2) + 4 * n + (i & 3); }

struct Unit { int pm, pn; };
struct Gemm { const bf16_t* A; const bf16_t* Bt; int M, N, K, lda, ldb, a_pn_off; };

struct StaticOrder {
    int nM, nN, nwg, G, c;
    __host__ __device__ void init(int M, int N, int G_, int c_) { nM = M / BM; nN = N / BM; nwg = nM * nN; G = G_; c = c_; }
    __host__ __device__ bool next(int i, Unit& u) const {
        const long L = (long)i * G + c; if (L >= nwg) return false;
        int wgid = (int)L; { const int q = nwg / NXCD, r = nwg % NXCD, xcd = wgid % NXCD, off = wgid / NXCD; wgid = (xcd < r ? xcd * (q + 1) : r * (q + 1) + (xcd - r) * q) + off; }
        const int nig = WGM * nN, gid = wgid / nig, fm = gid * WGM, gsz = (nM - fm) < WGM ? (nM - fm) : WGM;
        u.pm = fm + ((wgid % nig) % gsz); u.pn = (wgid % nig) / gsz; return true;
    }
    __device__ __forceinline__ void a_ready(const Unit&) const {}
    __device__ __forceinline__ void done(const Unit&) const {}
};

__device__ __forceinline__ unsigned cvt_pk_bf16(float lo, float hi) { unsigned r; asm volatile("v_cvt_pk_bf16_f32 %0, %1, %2" : "=v"(r) : "v"(lo), "v"(hi)); return r; }

struct EpiF32 {
    static constexpr bool PERM = false, AFTER_DRAIN = false;
    float* C; int ldc, pad;
    __device__ __forceinline__ void operator()(const f32x4 (&acc)[2][2][4][2], const Unit& u, int wr, int wc, int fr, int fq) const {
        const int row0 = u.pm * BM + wr * 64 + fr, col0 = u.pn * BM + wc * 32 + 4 * fq;
#pragma unroll
        for (int ai = 0; ai < 2; ++ai)
#pragma unroll
            for (int m = 0; m < 4; ++m) { float* rowp = C + (size_t)(row0 + ai * HALF + m * 16) * ldc + col0;
#pragma unroll
                for (int bj = 0; bj < 2; ++bj)
#pragma unroll
                    for (int n = 0; n < 2; ++n) *(f32x4*)(rowp + bj * HALF + n * 16) = acc[ai][bj][m][n]; }
    }
};
struct EpiBf16 {
    static constexpr bool PERM = true, AFTER_DRAIN = false;
    bf16_t* O; int ldc, pad;
    __device__ __forceinline__ void operator()(const f32x4 (&acc)[2][2][4][2], const Unit& u, int wr, int wc, int fr, int fq) const {
        const int row0 = u.pm * BM + wr * 64 + fr; const int col0 = u.pn * BM + wc * 32 + 8 * fq;
#pragma unroll
        for (int ai = 0; ai < 2; ++ai)
#pragma unroll
            for (int m = 0; m < 4; ++m) { bf16_t* rowp = O + (size_t)(row0 + ai * HALF + m * 16) * ldc + col0;
#pragma unroll
                for (int bj = 0; bj < 2; ++bj) { const f32x4 v0 = acc[ai][bj][m][0], v1 = acc[ai][bj][m][1];
                    u32x4 w; w.x = cvt_pk_bf16(v0[0], v0[1]); w.y = cvt_pk_bf16(v0[2], v0[3]); w.z = cvt_pk_bf16(v1[0], v1[1]); w.w = cvt_pk_bf16(v1[2], v1[3]);
                    *(u32x4*)(rowp + bj * HALF) = w; } }
    }
};
__device__ __forceinline__ float silu_f(float x) { return x * __builtin_amdgcn_rcpf(1.0f + __expf(-x)); }
struct EpiSwiGLU {
    static constexpr bool PERM = true, AFTER_DRAIN = false;
    bf16_t* O; int ldc, pad;
    __device__ __forceinline__ void operator()(const f32x4 (&acc)[2][2][4][2], const Unit& u, int wr, int wc, int fr, int fq) const {
        const int row0 = u.pm * BM + wr * 64 + fr; const int col0 = u.pn * HALF + wc * 32 + 8 * fq;
#pragma unroll
        for (int ai = 0; ai < 2; ++ai)
#pragma unroll
            for (int m = 0; m < 4; ++m) { bf16_t* rowp = O + (size_t)(row0 + ai * HALF + m * 16) * ldc + col0;
                const f32x4 g0 = acc[ai][0][m][0], g1 = acc[ai][0][m][1], u0 = acc[ai][1][m][0], u1 = acc[ai][1][m][1];
                float h[8];
#pragma unroll
                for (int j = 0; j < 4; ++j) { h[j] = silu_f(g0[j]) * u0[j]; h[4 + j] = silu_f(g1[j]) * u1[j]; }
                u32x4 w; w.x = cvt_pk_bf16(h[0], h[1]); w.y = cvt_pk_bf16(h[2], h[3]); w.z = cvt_pk_bf16(h[4], h[5]); w.w = cvt_pk_bf16(h[6], h[7]);
                *(u32x4*)rowp = w; }
    }
};

template <class Epi, class Sched, bool ALIGN_EPI = false, bool SP2 = false>
__device__ __forceinline__ void gemm_phase(PG8_LAS unsigned char* lds, const Gemm g, const Sched& S, const Epi& E) {
    const int tid = threadIdx.x, wid = __builtin_amdgcn_readfirstlane(tid >> 6), lane = tid & 63, wr = wid >> 2, wc = wid & 3, fr = lane & 15, fq = lane >> 4;
    const int K = g.K, nt = K / BK;
    unsigned voffA[2], voffB[2];
#pragma unroll
    for (int i = 0; i < 2; ++i) { int R, C; stage_rc(tid * 16 + i * 8192, R, C); const int Rb = Epi::PERM ? ((R & ~31) + perm32(R & 31)) : R;
        voffA[i] = (unsigned)(R * g.lda + C) * 2u; voffB[i] = (unsigned)(Rb * g.ldb + C) * 2u; }
    const size_t kstep = (size_t)(BK * 2);
    const size_t hstepA = (size_t)HALF * g.lda * 2, hstepB = (size_t)HALF * g.ldb * 2;
    const size_t tstepA = 2 * hstepA, tstepB = 2 * hstepB;
    const size_t pnoffA = (size_t)g.a_pn_off * 2;
    const unsigned ldsw = (unsigned)wid * 1024u;
    const int aoff = lds_byte(wr * 64 + fr, fq * 8), boff = lds_byte(wc * 32 + fr, fq * 8);
#define PG8_SA(b, h) (((b) * 2 + (h)) * HTB)
#define PG8_SB(b, h) ((4 + (b) * 2 + (h)) * HTB)
#define PG8_STAGE(bufoff, gbase, voff) do { _Pragma("unroll") for (int _i = 0; _i < 2; ++_i) \
        __builtin_amdgcn_global_load_lds((const unsigned*)((const char*)(gbase) + (voff)[_i]), (PG8_LAS unsigned*)(lds + (bufoff) + ldsw + _i * 8192), 16, 0, 0); } while (0)
#define PG8_LDA(dst, b, h) do { _Pragma("unroll") for (int m = 0; m < 4; ++m) _Pragma("unroll") for (int k = 0; k < 2; ++k) dst[m][k] = *(const PG8_LAS bf16x8*)(lds + PG8_SA(b, h) + aoff + m * 2048 + k * 1024); } while (0)
#define PG8_LDB(dst, b, h) do { _Pragma("unroll") for (int n = 0; n < 2; ++n) _Pragma("unroll") for (int k = 0; k < 2; ++k) dst[n][k] = *(const PG8_LAS bf16x8*)(lds + PG8_SB(b, h) + boff + n * 2048 + k * 1024); } while (0)
#define PG8_MMA(ai, bj, At, Bt) do { __builtin_amdgcn_s_setprio(1); _Pragma("unroll") for (int m = 0; m < 4; ++m) _Pragma("unroll") for (int n = 0; n < 2; ++n) _Pragma("unroll") for (int k = 0; k < 2; ++k) \
        acc[ai][bj][m][n] = __builtin_amdgcn_mfma_f32_16x16x32_bf16(Bt[n][k], At[m][k], acc[ai][bj][m][n], 0, 0, 0); __builtin_amdgcn_s_setprio(0); } while (0)
#define PG8_WAIT_V(n) asm volatile("s_waitcnt vmcnt(" #n ")" ::: "memory")
#define PG8_WAIT_L(n) asm volatile("s_waitcnt lgkmcnt(" #n ")" ::: "memory")
#define PG8_BAR __builtin_amdgcn_s_barrier()
#define PG8_SCHED __builtin_amdgcn_sched_barrier(0)
    Unit cur, nxt; int ui = 0;
    if (!S.next(0, cur)) return;
    f32x4 acc[2][2][4][2];
#pragma unroll
    for (int a = 0; a < 2; ++a)
#pragma unroll
        for (int b = 0; b < 2; ++b)
#pragma unroll
            for (int m = 0; m < 4; ++m)
#pragma unroll
                for (int n = 0; n < 2; ++n) acc[a][b][m][n] = (f32x4){0.f, 0.f, 0.f, 0.f};
    bf16x8 At[4][2], B0[2][2], B1[2][2];
    const char* cA = (const char*)g.A + (size_t)cur.pm * tstepA + (size_t)cur.pn * pnoffA; const char* cB = (const char*)g.Bt + (size_t)cur.pn * tstepB;
    S.a_ready(cur);
    if constexpr (SP2) {
        PG8_STAGE(PG8_SB(0, 0), cB, voffB); PG8_STAGE(PG8_SB(0, 1), cB + hstepB, voffB); PG8_STAGE(PG8_SA(0, 0), cA, voffA); PG8_STAGE(PG8_SA(0, 1), cA + hstepA, voffA);
        if (wr == 1) PG8_BAR;
        PG8_WAIT_V(2); PG8_BAR;
        PG8_STAGE(PG8_SB(1, 0), cB + kstep, voffB); PG8_STAGE(PG8_SA(1, 0), cA + kstep, voffA); PG8_STAGE(PG8_SB(1, 1), cB + hstepB + kstep, voffB);
        PG8_WAIT_V(6); PG8_BAR;
    } else {
        PG8_STAGE(PG8_SB(0, 0), cB, voffB); PG8_STAGE(PG8_SA(0, 0), cA, voffA); PG8_STAGE(PG8_SB(0, 1), cB + hstepB, voffB); PG8_STAGE(PG8_SA(0, 1), cA + hstepA, voffA);
        if (wr == 1) PG8_BAR;
        PG8_WAIT_V(4); PG8_BAR;
        PG8_STAGE(PG8_SB(1, 0), cB + kstep, voffB); PG8_STAGE(PG8_SA(1, 0), cA + kstep, voffA); PG8_STAGE(PG8_SB(1, 1), cB + hstepB + kstep, voffB);
        PG8_WAIT_V(6); PG8_BAR;
    }
    for (;;) {
        const bool has_next = S.next(ui + 1, nxt);
        const char* nA = has_next ? (const char*)g.A + (size_t)nxt.pm * tstepA + (size_t)nxt.pn * pnoffA : cA; const char* nB = has_next ? (const char*)g.Bt + (size_t)nxt.pn * tstepB : cB;
        for (int t = 0; t < nt; t += 2) {
            const bool last = (t == nt - 2);
            const char* a1 = cA + (size_t)(t + 1) * kstep;
            const char* a2 = last ? nA : cA + (size_t)(t + 2) * kstep; const char* b2 = last ? nB : cB + (size_t)(t + 2) * kstep;
            const char* a3 = a2 + kstep; const char* b3 = b2 + kstep;
            if (last && has_next) S.a_ready(nxt);
            if constexpr (SP2) {
            PG8_LDB(B0, 0, 0); PG8_LDB(B1, 0, 1); PG8_SCHED; PG8_LDA(At, 0, 0); PG8_STAGE(PG8_SA(1, 1), a1 + hstepA, voffA);
            PG8_WAIT_V(8); PG8_WAIT_L(0); PG8_BAR; PG8_MMA(0, 0, At, B0); PG8_MMA(0, 1, At, B1); PG8_BAR; PG8_SCHED;
            PG8_LDA(At, 0, 1); PG8_STAGE(PG8_SB(0, 0), b2, voffB); PG8_STAGE(PG8_SB(0, 1), b2 + hstepB, voffB); PG8_STAGE(PG8_SA(0, 0), a2, voffA);
            PG8_WAIT_V(8); PG8_WAIT_L(0); PG8_BAR; PG8_MMA(1, 0, At, B0); PG8_MMA(1, 1, At, B1); PG8_BAR; PG8_SCHED;
            PG8_LDB(B0, 1, 0); PG8_LDB(B1, 1, 1); PG8_SCHED; PG8_LDA(At, 1, 0); PG8_STAGE(PG8_SA(0, 1), a2 + hstepA, voffA);
            PG8_WAIT_V(8); PG8_WAIT_L(0); PG8_BAR; PG8_MMA(0, 0, At, B0); PG8_MMA(0, 1, At, B1); PG8_BAR; PG8_SCHED;
            PG8_LDA(At, 1, 1); PG8_STAGE(PG8_SB(1, 0), b3, voffB); PG8_STAGE(PG8_SB(1, 1), b3 + hstepB, voffB); PG8_STAGE(PG8_SA(1, 0), a3, voffA);
            PG8_WAIT_V(8); PG8_WAIT_L(0); PG8_BAR; PG8_MMA(1, 0, At, B0); PG8_MMA(1, 1, At, B1); PG8_BAR; PG8_SCHED;
            } else {
            PG8_LDB(B0, 0, 0); PG8_SCHED; PG8_LDA(At, 0, 0); PG8_STAGE(PG8_SA(1, 1), a1 + hstepA, voffA);
            PG8_WAIT_L(8); PG8_BAR; PG8_WAIT_L(0); PG8_MMA(0, 0, At, B0); PG8_BAR; PG8_SCHED;
            PG8_LDB(B1, 0, 1); PG8_STAGE(PG8_SB(0, 0), b2, voffB);
            PG8_BAR; PG8_WAIT_L(0); PG8_MMA(0, 1, At, B1); PG8_BAR;
            PG8_LDA(At, 0, 1); PG8_STAGE(PG8_SA(0, 0), a2, voffA);
            PG8_BAR; PG8_WAIT_L(0); PG8_MMA(1, 0, At, B0); PG8_BAR; PG8_SCHED;
            PG8_STAGE(PG8_SB(0, 1), b2 + hstepB, voffB);
            PG8_WAIT_V(6); PG8_BAR; PG8_MMA(1, 1, At, B1); PG8_BAR;
            PG8_LDB(B0, 1, 0); PG8_SCHED; PG8_LDA(At, 1, 0); PG8_STAGE(PG8_SA(0, 1), a2 + hstepA, voffA);
            PG8_WAIT_L(8); PG8_BAR; PG8_WAIT_L(0); PG8_MMA(0, 0, At, B0); PG8_BAR; PG8_SCHED;
            PG8_LDB(B1, 1, 1); PG8_STAGE(PG8_SB(1, 0), b3, voffB);
            PG8_BAR; PG8_WAIT_L(0); PG8_MMA(0, 1, At, B1); PG8_BAR;
            PG8_LDA(At, 1, 1); PG8_STAGE(PG8_SA(1, 0), a3, voffA);
            PG8_BAR; PG8_WAIT_L(0); PG8_MMA(1, 0, At, B0); PG8_BAR; PG8_SCHED;
            PG8_STAGE(PG8_SB(1, 1), b3 + hstepB, voffB);
            PG8_WAIT_V(6); PG8_BAR; PG8_MMA(1, 1, At, B1); PG8_BAR;
            }
        }
        if constexpr (ALIGN_EPI) { if (wr == 0) PG8_BAR; }
        if constexpr (!Epi::AFTER_DRAIN) { E(acc, cur, wr, wc, fr, fq); S.done(cur); }
        if (!has_next) break;
#pragma unroll
        for (int a = 0; a < 2; ++a)
#pragma unroll
            for (int b = 0; b < 2; ++b)
#pragma unroll
                for (int m = 0; m < 4; ++m)
#pragma unroll
                    for (int n = 0; n < 2; ++n) acc[a][b][m][n] = (f32x4){0.f, 0.f, 0.f, 0.f};
        cur = nxt; cA = nA; cB = nB; ++ui;
        if constexpr (ALIGN_EPI) { if (wr == 1) PG8_BAR; }
    }
    PG8_WAIT_V(0);
    if constexpr (!ALIGN_EPI) { if (wr == 0) PG8_BAR; }
    PG8_BAR;
    if constexpr (Epi::AFTER_DRAIN) { E.fused(acc, cur, wr, wc, fr, fq, lds, wid, lane); S.done(cur); }
#undef PG8_SA
#undef PG8_SB
#undef PG8_STAGE
#undef PG8_LDA
#undef PG8_LDB
#undef PG8_MMA
#undef PG8_WAIT_V
#undef PG8_WAIT_L
#undef PG8_BAR
#undef PG8_SCHED
}
}
namespace cfg {
constexpr int D = 1024, BATCH = 8, SEQ = 2048, MP = BATCH * SEQ, MS = 128, MR = MP + MS, MPAD = 16640;
constexpr int MH = 4, MDK = 256, MDV = 256;
constexpr int SH = 16, SP = 64, SG = 2, SN = 128, CONVD = 1536;
constexpr int INDIM = 6680, NIN = 6912, FF = 2816, NGU = 2 * FF, MIX = 2048;
constexpr float EPS = 1e-6f, GATE_CAP = 15.0f;
constexpr int PQ = 0, PK = 1024, PV = 2048, PO = 3072, PZ = 4096, PX = 5120, PG = 6656;
constexpr int GW = 40;
enum { I_XP = 0, I_XS, I_SC, I_SN, I_SM, I_SSSM, I_SCONV, I_SPOOL, I_GMIXPRE, I_GMIXPOST, I_GFFNPRE, I_GFFNPOST, I_WIN, I_BIG, I_BFG, I_GMLSTM,
       I_CONVW, I_CONVB, I_DTBIAS, I_ALOG, I_DSKIP, I_GSSM, I_WOUT, I_WPOOL, I_POOLSCALE, I_WGATE, I_WUP, I_WDOWN, N_IN };
constexpr size_t O_Y = 0;
constexpr size_t O_CP = O_Y + (size_t)MR * D;
constexpr size_t O_CS = O_CP + (size_t)BATCH * MH * MDK * MDV;
constexpr size_t O_NP = O_CS + (size_t)MS * MH * MDK * MDV;
constexpr size_t O_NS = O_NP + (size_t)BATCH * MH * MDK;
constexpr size_t O_MP = O_NS + (size_t)MS * MH * MDK;
constexpr size_t O_MS = O_MP + (size_t)BATCH * MH;
constexpr size_t O_SSP = O_MS + (size_t)MS * MH;
constexpr size_t O_SSS = O_SSP + (size_t)BATCH * SH * SP * SN;
constexpr size_t O_CVP = O_SSS + (size_t)MS * SH * SP * SN;
constexpr size_t O_CVS = O_CVP + (size_t)BATCH * 3 * CONVD;
constexpr size_t O_PLP = O_CVS + (size_t)MS * 3 * CONVD;
constexpr size_t O_PLS = O_PLP + (size_t)BATCH * 15 * D;
constexpr size_t O_END = O_PLS + (size_t)MS * 15 * D;
static_assert(O_END == 73241120, "output size");
constexpr size_t al(size_t x) { return (x + 4095) & ~(size_t)4095; }
constexpr size_t WS_CTL = 0, CTL_BYTES = 1u << 20;
constexpr size_t WS_WIN = WS_CTL + CTL_BYTES;
constexpr size_t WS_WOUT = WS_WIN + al((size_t)NIN * D * 2);
constexpr size_t WS_WGU = WS_WOUT + al((size_t)D * MIX * 2);
constexpr size_t WS_WDN = WS_WGU + 2 * al((size_t)NGU * D * 2);
constexpr size_t WS_WPOOL = WS_WDN + 2 * al((size_t)D * FF * 2);
constexpr size_t WS_U = WS_WPOOL + al((size_t)D * 256 * 2);
constexpr size_t WS_G = WS_U + al((size_t)MPAD * D * 2);
constexpr size_t WS_XC = WS_G + al((size_t)MR * GW * 4);
constexpr size_t WS_HY = WS_XC + al((size_t)MR * CONVD * 2);
constexpr size_t WS_PROJ = WS_HY + al((size_t)MPAD * MIX * 2);
constexpr size_t WS_OUTF = WS_PROJ;
constexpr size_t WS_HMID = WS_OUTF + al((size_t)MPAD * D * 4);
constexpr size_t WS_U2F = WS_HMID + al((size_t)MPAD * FF * 2);
constexpr size_t WS_END0 = WS_PROJ + al((size_t)MPAD * NIN * 2);
constexpr size_t WS_END1 = WS_U2F + al((size_t)MR * D * 4);
constexpr size_t WS_END = WS_END0 > WS_END1 ? WS_END0 : WS_END1;
}

typedef unsigned short bf16;
#define LAS __attribute__((address_space(3)))
typedef float f32x4 __attribute__((ext_vector_type(4)));
typedef unsigned u32x4 __attribute__((ext_vector_type(4)));
typedef unsigned u32x2 __attribute__((ext_vector_type(2)));

__device__ __forceinline__ unsigned f2bf(float f) { unsigned u = __builtin_bit_cast(unsigned, f); return (u + 0x7fffu + ((u >> 16) & 1u)) >> 16; }
__device__ __forceinline__ unsigned pk2(float lo, float hi) { return f2bf(lo) | (f2bf(hi) << 16); }
__device__ __forceinline__ float bf2f(unsigned short b) { return __builtin_bit_cast(float, (unsigned)b << 16); }
__device__ __forceinline__ float bflo(unsigned w) { return __builtin_bit_cast(float, w << 16); }
__device__ __forceinline__ float bfhi(unsigned w) { return __builtin_bit_cast(float, w & 0xffff0000u); }
__device__ __forceinline__ f32x4 ld_bf4(const bf16* p) { const u32x2 w = *(const u32x2*)p; return (f32x4){bflo(w.x), bfhi(w.x), bflo(w.y), bfhi(w.y)}; }
__device__ __forceinline__ void st_bf4(bf16* p, f32x4 v) { u32x2 w; w.x = pk2(v.x, v.y); w.y = pk2(v.z, v.w); *(u32x2*)p = w; }
__device__ __forceinline__ float wave_sum(float v) {
#pragma unroll
    for (int o = 1; o < 64; o <<= 1) v += __shfl_xor(v, o);
    return v;
}
__device__ __forceinline__ float sigmoid_f(float x) { return 1.0f / (1.0f + expf(-x)); }
__device__ __forceinline__ float silu_x(float x) { return x / (1.0f + expf(-x)); }
__device__ __forceinline__ float softplus_f(float x) { return fmaxf(x, 0.f) + log1pf(expf(-fabsf(x))); }
__device__ __forceinline__ float softcap_f(float x) { return cfg::GATE_CAP * tanhf(x * (1.0f / cfg::GATE_CAP)); }
constexpr int NWAVES = 8, NTHREADS = NWAVES * 64;
constexpr int RING_OFF = 0, RING_BYTES = 131072;
constexpr int LDSCTL_OFF = RING_BYTES, MISC_OFF = LDSCTL_OFF + 320;
constexpr int LDS_BYTES = 147456;
constexpr int CW_TMO = 0, CW_CODE = 1, CW_BAR = 4096, CTL_ZERO_BYTES = 65536;
#define GAS __attribute__((address_space(1)))
typedef GAS unsigned gu32;
#define RLX_AGENT __ATOMIC_RELAXED, __HIP_MEMORY_SCOPE_AGENT

#define XB_TMO      128
#define XB_XCNT(j)  (256  + 64 * (j))
#define XB_XSUB(j)  (1280 + 64 * (j))
#define XB_XGEN(j)  (2304 + 64 * (j))
#define XB_TOP      3328
#define XB_TOPGEN   3392
#define XCD_BAR_WORDS 3456
#define XB_SPIN_CAP (1u << 22)
static_assert((CW_BAR + XCD_BAR_WORDS) * 4 <= CTL_ZERO_BYTES, "barrier words inside the memset region");

__device__ __forceinline__ unsigned xb_ld(unsigned* p)              { return __hip_atomic_load(p, __ATOMIC_RELAXED, __HIP_MEMORY_SCOPE_AGENT); }
__device__ __forceinline__ unsigned xb_add(unsigned* p, unsigned v) { return __hip_atomic_fetch_add(p, v, __ATOMIC_RELAXED, __HIP_MEMORY_SCOPE_AGENT); }
__device__ __forceinline__ unsigned xb_xcc_id() { return (unsigned)__builtin_amdgcn_s_getreg((3 << 11) | 20) & 0xFu; }
#define XB_SPIN(cond, bar) do { unsigned _sp = 0; while (cond) { __builtin_amdgcn_s_sleep(1); \
    if ((++_sp & 255u) == 0u) { if (xb_ld(&(bar)[XB_TMO])) break; if (_sp > XB_SPIN_CAP) { atomicAdd(&(bar)[XB_TMO], 1u); break; } } } } while (0)

struct XcdBarrier {
    unsigned* bar; unsigned x;
    volatile LAS unsigned* st;
};
__device__ __forceinline__ XcdBarrier xcd_barrier_post(unsigned* bar, volatile LAS unsigned* st) {
    XcdBarrier b; b.bar = bar; b.x = xb_xcc_id(); b.st = st;
    if (threadIdx.x == 0) (void)xb_add(&bar[XB_XCNT(b.x)], 1u);
    return b;
}
__device__ __forceinline__ void xcd_barrier_complete(unsigned* bar, unsigned x, unsigned& nloc, unsigned& nx) {
    const unsigned G = gridDim.x * gridDim.y * gridDim.z;
    unsigned sum, cnt, mine, sp = 0u;
    for (;;) {
        sum = 0u; cnt = 0u; mine = 0u;
#pragma unroll
        for (unsigned j = 0; j < 16; ++j) { const unsigned c = xb_ld(&bar[XB_XCNT(j)]); sum += c; cnt += (c > 0u) ? 1u : 0u; mine = (j == x) ? c : mine; }
        if (sum == G) break;
        __builtin_amdgcn_s_sleep(1);
        if ((++sp & 255u) == 0u) { if (xb_ld(&bar[XB_TMO])) break; if (sp > XB_SPIN_CAP) { atomicAdd(&bar[XB_TMO], 1u); break; } }
    }
    nloc = mine > 0u ? mine : 1u; nx = cnt > 0u ? cnt : 1u;
}
__device__ __forceinline__ void xcd_barrier(const XcdBarrier& b) {
    asm volatile("s_waitcnt vmcnt(0)" ::: "memory");
    __syncthreads();
    if (threadIdx.x == 0) {
        unsigned* bar = b.bar;
        __builtin_amdgcn_s_waitcnt(0);
        unsigned nloc = b.st[0], nx = b.st[1];
        if (nloc == 0u) { xcd_barrier_complete(bar, b.x, nloc, nx); b.st[0] = nloc; b.st[1] = nx; }
        const unsigned old = xb_add(&bar[XB_XSUB(b.x)], 1u);
        const unsigned gen = old / nloc;
        if (old + 1u == (gen + 1u) * nloc) {
            __builtin_amdgcn_fence(__ATOMIC_RELEASE, "agent");
            asm volatile("s_waitcnt vmcnt(0)" ::: "memory");
            const unsigned og = xb_add(&bar[XB_TOP], 1u);
            const unsigned tg = og / nx;
            if (og + 1u == (tg + 1u) * nx) xb_add(&bar[XB_TOPGEN], 1u);
            else XB_SPIN(xb_ld(&bar[XB_TOPGEN]) == tg, bar);
            __builtin_amdgcn_fence(__ATOMIC_ACQUIRE, "agent");
            xb_add(&bar[XB_XGEN(b.x)], 1u);
            asm volatile("s_waitcnt vmcnt(0)" ::: "memory");
        } else {
            XB_SPIN(xb_ld(&bar[XB_XGEN(b.x)]) == gen, bar);
            __builtin_amdgcn_fence(__ATOMIC_ACQUIRE, "agent");
            asm volatile("s_waitcnt vmcnt(0)" ::: "memory");
        }
    }
    __syncthreads();
}
using namespace cfg;
struct PrepMat { const float* W0; const float* W1; const float* scale; bf16* WT; int ldw, K, N, mode, nitems, pad; };
__device__ __forceinline__ void prep_item(const PrepMat& P, int item, LAS float* scr, int lane) {
    const int nblk = P.N / 32, kb = item / nblk, nb = item % nblk, k0 = 64 * kb, n0 = 32 * nb;
    const int n = n0 + (lane & 31);
    const float* W = P.W0; int sc = n; float mul = 1.0f;
    if (P.mode == 1) {
        if (n < 4096) { sc = n; if (n < 1024) mul = 0.0625f; }
        else if (n < 5120) sc = 4104 + (n - 4096);
        else if (n < 6656) sc = 5128 + (n - 5120);
        else if (n < 6664) sc = 4096 + (n - 6656);
        else if (n < 6680) sc = n;
        else sc = -1;
    } else if (P.mode == 2) {
        const int pn = n >> 8, w = n & 255; W = (w < 128) ? P.W0 : P.W1; sc = 128 * pn + (w & 127);
    } else if (P.mode == 3) {
        mul = P.scale[n];
    }
#pragma unroll 8
    for (int i = 0; i < 32; ++i) { const int kk = 2 * i + (lane >> 5); scr[kk * 33 + (lane & 31)] = (sc >= 0) ? W[(size_t)(k0 + kk) * P.ldw + sc] * mul : 0.f; }
    asm volatile("s_waitcnt lgkmcnt(0)" ::: "memory");
    const int c = lane & 7;
#pragma unroll
    for (int j = 0; j < 4; ++j) { const int nn = (lane >> 3) + 8 * j; const LAS float* s = scr + (8 * c) * 33 + nn;
        u32x4 o; o.x = pk2(s[0 * 33], s[1 * 33]); o.y = pk2(s[2 * 33], s[3 * 33]); o.z = pk2(s[4 * 33], s[5 * 33]); o.w = pk2(s[6 * 33], s[7 * 33]);
        *(u32x4*)(P.WT + (size_t)(n0 + nn) * P.K + k0 + 8 * c) = o; }
    asm volatile("s_waitcnt lgkmcnt(0)" ::: "memory");
}
__device__ __forceinline__ PrepMat mk_mat(const float* W0, const float* W1, const float* scale, int ldw, int K, int N, int mode, bf16* WT) {
    PrepMat m; m.W0 = W0; m.W1 = W1; m.scale = scale; m.WT = WT; m.ldw = ldw; m.K = K; m.N = N; m.mode = mode; m.nitems = (K / 64) * (N / 32); m.pad = 0; return m;
}
constexpr int PI_IN = (D / 64) * (NIN / 32), PI_OUT = (MIX / 64) * (D / 32), PI_GU = (D / 64) * (NGU / 32), PI_DN = (FF / 64) * (D / 32), PI_PL = (256 / 64) * (256 / 32);
constexpr int PI_TOTAL = PI_IN + PI_OUT + 2 * PI_GU + 2 * PI_DN + 4 * PI_PL;
__device__ __forceinline__ void prep_phase(const float* const* in, unsigned char* ws, LAS float* scr, int gw, int ngw, int lane) {
    for (int it = gw; it < PI_TOTAL; it += ngw) {
        int r = it; PrepMat m;
        if (r < PI_IN) m = mk_mat(in[I_WIN], nullptr, nullptr, INDIM, D, NIN, 1, (bf16*)(ws + WS_WIN));
        else if ((r -= PI_IN) < PI_OUT) m = mk_mat(in[I_WOUT], nullptr, nullptr, D, MIX, D, 0, (bf16*)(ws + WS_WOUT));
        else if ((r -= PI_OUT) < 2 * PI_GU) { const int l = r / PI_GU; r -= l * PI_GU;
            m = mk_mat(in[I_WGATE] + (size_t)l * D * FF, in[I_WUP] + (size_t)l * D * FF, nullptr, FF, D, NGU, 2, (bf16*)(ws + WS_WGU + l * al((size_t)NGU * D * 2))); }
        else if ((r -= 2 * PI_GU) < 2 * PI_DN) { const int l = r / PI_DN; r -= l * PI_DN;
            m = mk_mat(in[I_WDOWN] + (size_t)l * FF * D, nullptr, nullptr, D, FF, D, 0, (bf16*)(ws + WS_WDN + l * al((size_t)D * FF * 2))); }
        else { r -= 2 * PI_DN; const int g = r / PI_PL; r -= g * PI_PL;
            m = mk_mat(in[I_WPOOL] + (size_t)g * 65536, nullptr, in[I_POOLSCALE] + g * 256, 256, 256, 256, 3, (bf16*)(ws + WS_WPOOL) + (size_t)g * 65536); }
        prep_item(m, r, scr, lane);
    }
}

__device__ __forceinline__ const float* x_row(const float* xp, const float* xs, int r) { return r < MP ? xp + (size_t)r * D : xs + (size_t)(r - MP) * D; }

__device__ __forceinline__ void norm0_phase(const float* xp, const float* xs, const float* g, bf16* U, int gw, int ngw, int lane) {
    for (int r = gw; r < MPAD; r += ngw) {
        bf16* o = U + (size_t)r * D;
        if (r >= MR) {
#pragma unroll
            for (int j = 0; j < 4; ++j) *(u32x2*)(o + 4 * lane + 256 * j) = (u32x2){0u, 0u};
            continue; }
        const float* x = x_row(xp, xs, r);
        f32x4 v[4]; float ss = 0.f;
#pragma unroll
        for (int j = 0; j < 4; ++j) { v[j] = *(const f32x4*)(x + 4 * lane + 256 * j); ss += v[j].x * v[j].x + v[j].y * v[j].y + v[j].z * v[j].z + v[j].w * v[j].w; }
        const float rstd = 1.0f / sqrtf(wave_sum(ss) * (1.0f / D) + EPS);
#pragma unroll
        for (int j = 0; j < 4; ++j) { const f32x4 gg = *(const f32x4*)(g + 4 * lane + 256 * j); st_bf4(o + 4 * lane + 256 * j, v[j] * rstd * gg); }
    }
}

__device__ __forceinline__ void conv_phase(const bf16* proj, const float* sconv, const float* cw, const float* cb, const float* big, const float* bfg,
                                           const float* dtb, const float* alog, bf16* XC, float* G, float* out, size_t t0, size_t nthr) {
    for (size_t i = t0; i < (size_t)MR * (CONVD / 4); i += nthr) {
        const int r = (int)(i / (CONVD / 4)), c = 4 * (int)(i % (CONVD / 4));
        f32x4 acc = *(const f32x4*)(cb + c);
#pragma unroll
        for (int j = 0; j < 4; ++j) {
            f32x4 xv;
            if (r < MP) { const int t = r & (SEQ - 1); if (t - 3 + j < 0) continue; xv = ld_bf4(proj + (size_t)(r - 3 + j) * NIN + PX + c); }
            else { const int b = r - MP; if (j < 3) xv = *(const f32x4*)(sconv + ((size_t)b * 3 + j) * CONVD + c); else xv = ld_bf4(proj + (size_t)r * NIN + PX + c); }
            acc += xv * *(const f32x4*)(cw + (size_t)j * CONVD + c);
        }
        f32x4 y; y.x = silu_x(acc.x); y.y = silu_x(acc.y); y.z = silu_x(acc.z); y.w = silu_x(acc.w);
        st_bf4(XC + (size_t)r * CONVD + c, y);
    }
    for (size_t i = t0; i < (size_t)BATCH * 3 * (CONVD / 4); i += nthr) {
        const int c = 4 * (int)(i % (CONVD / 4)), j = (int)(i / (CONVD / 4)) % 3, b = (int)(i / (CONVD / 4)) / 3;
        *(f32x4*)(out + O_CVP + ((size_t)b * 3 + j) * CONVD + c) = ld_bf4(proj + (size_t)(b * SEQ + SEQ - 3 + j) * NIN + PX + c);
    }
    for (size_t i = t0; i < (size_t)MS * 3 * (CONVD / 4); i += nthr) {
        const int c = 4 * (int)(i % (CONVD / 4)), j = (int)(i / (CONVD / 4)) % 3, b = (int)(i / (CONVD / 4)) / 3;
        f32x4 v; if (j < 2) v = *(const f32x4*)(sconv + ((size_t)b * 3 + j + 1) * CONVD + c); else v = ld_bf4(proj + (size_t)(MP + b) * NIN + PX + c);
        *(f32x4*)(out + O_CVS + ((size_t)b * 3 + j) * CONVD + c) = v;
    }
    for (size_t i = t0; i < (size_t)MR * 24; i += nthr) {
        const int r = (int)(i / 24), k = (int)(i % 24);
        const float pre = bf2f(proj[(size_t)r * NIN + PG + k]);
        float* g = G + (size_t)r * GW;
        if (k < 4) g[k] = softcap_f(pre + big[k]);
        else if (k < 8) { const float x = softcap_f(pre + bfg[k - 4]); g[k] = fminf(x, 0.f) - log1pf(expf(-fabsf(x))); }
        else { const int hd = k - 8; const float dt = softplus_f(pre + dtb[hd]); g[8 + hd] = dt; g[24 + hd] = -dt * expf(alog[hd]); }
    }
}

constexpr int MLN_LDS_F = 4096 + 4096 + 512 + 4096 + 64 + 80 + 16;
__device__ __forceinline__ void mlstm_prompt_naive(const bf16* proj, const float* G, bf16* HY, float* out, int item, LAS float* L, int tid  ) {
    const int vs = item & 7, h = (item >> 3) & 3, b = item >> 5;
    const int dg = tid >> 5, vv = tid & 31, lane = tid & 63, wave = tid >> 6;
    LAS float* qs = L; LAS float* ks = L + 4096; LAS float* vsh = L + 8192; LAS float* pnum = L + 8704; LAS float* pqn = L + 12800;
    LAS float* mts = L + 12864; LAS float* decs = mts + 16; LAS float* wsh = mts + 32; LAS float* lis = mts + 48; LAS float* lfs = mts + 64; LAS float* mc = mts + 80;
    float c[32];
#pragma unroll
    for (int i = 0; i < 32; ++i) c[i] = 0.f;
    float nd = 0.f;
    if (tid == 0) mc[0] = 0.f;
    for (int t0 = 0; t0 < SEQ; t0 += 16) {
        __syncthreads();
        const size_t row0 = (size_t)b * SEQ + t0;
        for (int tt = 0; tt < 16; ++tt) {
            qs[tt * 256 + tid] = bf2f(proj[(row0 + tt) * NIN + PQ + h * 256 + tid]);
            ks[tt * 256 + tid] = bf2f(proj[(row0 + tt) * NIN + PK + h * 256 + tid]);
        }
        for (int e = tid; e < 16 * 32; e += 256) { const int tt = e >> 5, v = e & 31; vsh[e] = bf2f(proj[(row0 + tt) * NIN + PV + h * 256 + vs * 32 + v]); }
        if (tid < 16) { lis[tid] = G[(row0 + tid) * GW + h]; lfs[tid] = G[(row0 + tid) * GW + 4 + h]; }
        __syncthreads();
        if (tid == 0) {
            float m = mc[0];
            for (int tt = 0; tt < 16; ++tt) { const float li = lis[tt], lf = lfs[tt]; const float mn = fmaxf(lf + m, li); decs[tt] = expf(lf + m - mn); wsh[tt] = expf(li - mn); mts[tt] = mn; m = mn; }
            mc[0] = m;
        }
        __syncthreads();
        for (int tt = 0; tt < 16; ++tt) {
            const float dec = decs[tt], w = wsh[tt];
            const float vval = vsh[tt * 32 + vv] * w;
            float acc = 0.f;
#pragma unroll
            for (int i = 0; i < 32; ++i) { c[i] = dec * c[i] + ks[tt * 256 + dg * 32 + i] * vval; acc += qs[tt * 256 + dg * 32 + i] * c[i]; }
            pnum[(tt * 8 + dg) * 32 + vv] = acc;
            nd = dec * nd + w * ks[tt * 256 + tid];
            const float qn = wave_sum(qs[tt * 256 + tid] * nd);
            if (lane == 0) pqn[tt * 4 + wave] = qn;
        }
        __syncthreads();
#pragma unroll
        for (int rep = 0; rep < 2; ++rep) {
            const int tt = (tid >> 5) + 8 * rep;
            float num = 0.f;
#pragma unroll
            for (int g8 = 0; g8 < 8; ++g8) num += pnum[(tt * 8 + g8) * 32 + vv];
            const float den = (pqn[tt * 4 + 0] + pqn[tt * 4 + 1]) + (pqn[tt * 4 + 2] + pqn[tt * 4 + 3]);
            const float hval = num / fmaxf(fabsf(den), expf(-mts[tt]));
            HY[(row0 + tt) * MIX + h * 256 + vs * 32 + vv] = (bf16)f2bf(hval);
        }
    }
    __syncthreads();
#pragma unroll
    for (int i = 0; i < 32; ++i) out[O_CP + ((size_t)(b * MH + h) * MDK + dg * 32 + i) * MDV + vs * 32 + vv] = c[i];
    if (vs == 0) { out[O_NP + (size_t)(b * MH + h) * MDK + tid] = nd; if (tid == 0) out[O_MP + b * MH + h] = mc[0]; }
}

__device__ __forceinline__ void mlstm_sample_item(const bf16* proj, const float* G, const float* cin, const float* nin, const float* min_, bf16* HY, float* out, int item, LAS float* L, int tid) {
    const int h = item & 3, b = item >> 2, lane = tid & 63, wave = tid >> 6;
    const size_t row = (size_t)MP + b;
    LAS float* qs = L; LAS float* ks = L + 256; LAS float* red = L + 512; LAS float* qnr = L + 1536;
    __syncthreads();
    qs[tid] = bf2f(proj[row * NIN + PQ + h * 256 + tid]); ks[tid] = bf2f(proj[row * NIN + PK + h * 256 + tid]);
    const float li = G[row * GW + h], lf = G[row * GW + 4 + h], m = min_[b * MH + h];
    const float mn = fmaxf(lf + m, li), dec = expf(lf + m - mn), w = expf(li - mn);
    __syncthreads();
    const float nd = dec * nin[(size_t)(b * MH + h) * MDK + tid] + w * ks[tid];
    out[O_NS + (size_t)(b * MH + h) * MDK + tid] = nd;
    const float qn = wave_sum(qs[tid] * nd);
    if (lane == 0) qnr[wave] = qn;
    const int dq = tid >> 6, v4 = tid & 63;
    const f32x4 vv = ld_bf4(proj + row * NIN + PV + h * 256 + 4 * v4) * w;
    f32x4 acc = (f32x4){0.f, 0.f, 0.f, 0.f};
    const float* cbase = cin + ((size_t)(b * MH + h) * MDK) * MDV + 4 * v4;
    float* obase = out + O_CS + ((size_t)(b * MH + h) * MDK) * MDV + 4 * v4;
    for (int d = dq * 64; d < dq * 64 + 64; ++d) {
        const f32x4 c4 = *(const f32x4*)(cbase + (size_t)d * MDV);
        const f32x4 cn = c4 * dec + vv * ks[d];
        *(f32x4*)(obase + (size_t)d * MDV) = cn;
        acc += cn * qs[d];
    }
    red[dq * 256 + 4 * v4 + 0] = acc.x; red[dq * 256 + 4 * v4 + 1] = acc.y; red[dq * 256 + 4 * v4 + 2] = acc.z; red[dq * 256 + 4 * v4 + 3] = acc.w;
    __syncthreads();
    const float num = (red[tid] + red[256 + tid]) + (red[512 + tid] + red[768 + tid]);
    const float den = (qnr[0] + qnr[1]) + (qnr[2] + qnr[3]);
    HY[row * MIX + h * 256 + tid] = (bf16)f2bf(num / fmaxf(fabsf(den), expf(-mn)));
    if (tid == 0) out[O_MS + b * MH + h] = mn;
}

constexpr int SSN_LDS_F = 1024 + 2304 + 2304 + 32;
__device__ __forceinline__ void ssd_prompt_naive(const bf16* XC, const float* G, const float* dskip, bf16* HY, float* out, int item, LAS float* L, int tid) {
    const int head = item & 15, b = item >> 4, g = head >> 3;
    const int p = tid >> 2, nq = tid & 3;
    LAS float* xs = L; LAS float* Bs = L + 1024; LAS float* Cs = L + 3328; LAS float* dts = L + 5632; LAS float* as_ = L + 5648;
    float hst[32];
#pragma unroll
    for (int i = 0; i < 32; ++i) hst[i] = 0.f;
    const float dsk = dskip[head];
    for (int t0 = 0; t0 < SEQ; t0 += 16) {
        __syncthreads();
        const size_t row0 = (size_t)b * SEQ + t0;
        for (int e = tid; e < 16 * 64; e += 256) { const int tt = e >> 6, pp = e & 63; xs[e] = bf2f(XC[(row0 + tt) * CONVD + head * 64 + pp]); }
        for (int e = tid; e < 16 * 128; e += 256) { const int tt = e >> 7, n = e & 127;
            Bs[(tt * 4 + (n >> 5)) * 36 + (n & 31)] = bf2f(XC[(row0 + tt) * CONVD + 1024 + g * 128 + n]);
            Cs[(tt * 4 + (n >> 5)) * 36 + (n & 31)] = bf2f(XC[(row0 + tt) * CONVD + 1280 + g * 128 + n]); }
        if (tid < 16) { dts[tid] = G[(row0 + tid) * GW + 8 + head]; as_[tid] = G[(row0 + tid) * GW + 24 + head]; }
        __syncthreads();
        for (int tt = 0; tt < 16; ++tt) {
            const float decay = expf(as_[tt]), xv = xs[tt * 64 + p], coef = dts[tt] * xv;
            float acc = 0.f;
#pragma unroll
            for (int i = 0; i < 32; ++i) { hst[i] = decay * hst[i] + coef * Bs[(tt * 4 + nq) * 36 + i]; acc += Cs[(tt * 4 + nq) * 36 + i] * hst[i]; }
            acc += __shfl_xor(acc, 1); acc += __shfl_xor(acc, 2);
            if (nq == 0) HY[(row0 + tt) * MIX + 1024 + head * 64 + p] = (bf16)f2bf(acc + dsk * xv);
        }
    }
#pragma unroll
    for (int i = 0; i < 32; ++i) out[O_SSP + ((size_t)(b * SH + head) * SP + p) * SN + nq * 32 + i] = hst[i];
}

__device__ __forceinline__ void ssd_sample_item(const bf16* XC, const float* G, const float* dskip, const float* sin_, bf16* HY, float* out, int item, int tid) {
    const int head = item & 15, b = item >> 4, g = head >> 3;
    const int pj = tid >> 5, n4 = tid & 31;
    const size_t row = (size_t)MP + b;
    const float dt = G[row * GW + 8 + head], decay = expf(G[row * GW + 24 + head]), dsk = dskip[head];
    const f32x4 B4 = ld_bf4(XC + row * CONVD + 1024 + g * 128 + 4 * n4), C4 = ld_bf4(XC + row * CONVD + 1280 + g * 128 + 4 * n4);
#pragma unroll
    for (int j = 0; j < 8; ++j) {
        const int p = pj + 8 * j;
        const float xv = bf2f(XC[row * CONVD + head * 64 + p]);
        const size_t off = ((size_t)(b * SH + head) * SP + p) * SN + 4 * n4;
        const f32x4 hn = *(const f32x4*)(sin_ + off) * decay + B4 * (dt * xv);
        *(f32x4*)(out + O_SSS + off) = hn;
        float acc = C4.x * hn.x + C4.y * hn.y + C4.z * hn.z + C4.w * hn.w;
#pragma unroll
        for (int o = 1; o < 32; o <<= 1) acc += __shfl_xor(acc, o);
        if (n4 == 0) HY[row * MIX + 1024 + head * 64 + p] = (bf16)f2bf(acc + dsk * xv);
    }
}

__device__ __forceinline__ void finish_phase(const bf16* proj, const float* gml, const float* gssm, bf16* HY, int gw, int ngw, int lane) {
    for (int r = gw; r < MPAD; r += ngw) {
        bf16* hy = HY + (size_t)r * MIX;
        if (r >= MR) {
#pragma unroll
            for (int j = 0; j < 8; ++j) *(u32x2*)(hy + 4 * lane + 256 * j) = (u32x2){0u, 0u};
            continue; }
        const bf16* pr = proj + (size_t)r * NIN;
        f32x4 v[8]; float ss[8];
#pragma unroll
        for (int j = 0; j < 8; ++j) {
            v[j] = ld_bf4(hy + 4 * lane + 256 * j);
            if (j >= 4) { const f32x4 z = ld_bf4(pr + PZ + 4 * lane + 256 * (j - 4)); v[j].x *= silu_x(z.x); v[j].y *= silu_x(z.y); v[j].z *= silu_x(z.z); v[j].w *= silu_x(z.w); }
            ss[j] = wave_sum(v[j].x * v[j].x + v[j].y * v[j].y + v[j].z * v[j].z + v[j].w * v[j].w);
        }
#pragma unroll
        for (int j = 0; j < 8; ++j) {
            const int col = 4 * lane + 256 * j;
            f32x4 o;
            if (j < 4) {
                const float rstd = 1.0f / sqrtf(ss[j] * (1.0f / 256.0f) + EPS);
                const f32x4 gg = *(const f32x4*)(gml + col), og = ld_bf4(pr + PO + col);
                o = v[j] * rstd * gg; o.x *= sigmoid_f(og.x); o.y *= sigmoid_f(og.y); o.z *= sigmoid_f(og.z); o.w *= sigmoid_f(og.w);
            } else {
                const int j0 = 4 + ((j - 4) & ~1);
                const float rstd = 1.0f / sqrtf((ss[j0] + ss[j0 + 1]) * (1.0f / 512.0f) + EPS);
                o = v[j] * rstd * *(const f32x4*)(gssm + col - 1024);
            }
            st_bf4(hy + col, o);
        }
    }
}

__device__ __forceinline__ void rowpass_phase(const float* xp, const float* xs, const float* xin, const float* outf, const float* gpost, const float* gnext,
                                              float* xout, bf16* UB, float* UF, int gw, int ngw, int lane) {
    for (int r = gw; r < MPAD; r += ngw) {
        if (r >= MR) {
            if (UB) {
#pragma unroll
                for (int j = 0; j < 4; ++j) *(u32x2*)(UB + (size_t)r * D + 4 * lane + 256 * j) = (u32x2){0u, 0u}; }
            continue; }
        const float* xi = xin ? xin + (size_t)r * D : x_row(xp, xs, r);
        f32x4 o[4], x[4]; float ss = 0.f;
#pragma unroll
        for (int j = 0; j < 4; ++j) { o[j] = *(const f32x4*)(outf + (size_t)r * D + 4 * lane + 256 * j); x[j] = *(const f32x4*)(xi + 4 * lane + 256 * j);
            ss += o[j].x * o[j].x + o[j].y * o[j].y + o[j].z * o[j].z + o[j].w * o[j].w; }
        const float rstd = 1.0f / sqrtf(wave_sum(ss) * (1.0f / D) + EPS);
        float ss2 = 0.f;
#pragma unroll
        for (int j = 0; j < 4; ++j) { x[j] += o[j] * rstd * *(const f32x4*)(gpost + 4 * lane + 256 * j); *(f32x4*)(xout + (size_t)r * D + 4 * lane + 256 * j) = x[j];
            ss2 += x[j].x * x[j].x + x[j].y * x[j].y + x[j].z * x[j].z + x[j].w * x[j].w; }
        if (gnext) {
            const float rstd2 = 1.0f / sqrtf(wave_sum(ss2) * (1.0f / D) + EPS);
#pragma unroll
            for (int j = 0; j < 4; ++j) { const f32x4 u = x[j] * rstd2 * *(const f32x4*)(gnext + 4 * lane + 256 * j);
                if (UB) st_bf4(UB + (size_t)r * D + 4 * lane + 256 * j, u);
                if (UF) *(f32x4*)(UF + (size_t)r * D + 4 * lane + 256 * j) = u; }
        }
    }
}

__device__ __forceinline__ void pool_phase(const float* U2F, const float* spool, bf16* DP, float* out, size_t t0, size_t nthr) {
    for (size_t i = t0; i < (size_t)MPAD * (D / 4); i += nthr) {
        const int r = (int)(i / (D / 4)), c = 4 * (int)(i % (D / 4));
        if (r >= MR) { *(u32x2*)(DP + (size_t)r * D + c) = (u32x2){0u, 0u}; continue; }
        const int w = 2 << (c >> 8);
        const f32x4 u = *(const f32x4*)(U2F + (size_t)r * D + c);
        f32x4 s = u; float cnt;
        if (r < MP) { const int t = r & (SEQ - 1); const int n = (t + 1 < w) ? t + 1 : w; cnt = (float)n;
            for (int k = 1; k < n; ++k) s += *(const f32x4*)(U2F + (size_t)(r - k) * D + c); }
        else { const int b = r - MP; cnt = (float)w;
            for (int k = 1; k < w; ++k) s += *(const f32x4*)(spool + ((size_t)b * 15 + 15 - k) * D + c); }
        st_bf4(DP + (size_t)r * D + c, s / cnt - u);
    }
    for (size_t i = t0; i < (size_t)BATCH * 15 * (D / 4); i += nthr) {
        const int c = 4 * (int)(i % (D / 4)), j = (int)(i / (D / 4)) % 15, b = (int)(i / (D / 4)) / 15;
        *(f32x4*)(out + O_PLP + ((size_t)b * 15 + j) * D + c) = *(const f32x4*)(U2F + (size_t)(b * SEQ + SEQ - 15 + j) * D + c);
    }
    for (size_t i = t0; i < (size_t)MS * 15 * (D / 4); i += nthr) {
        const int c = 4 * (int)(i % (D / 4)), j = (int)(i / (D / 4)) % 15, b = (int)(i / (D / 4)) / 15;
        f32x4 v; if (j < 14) v = *(const f32x4*)(spool + ((size_t)b * 15 + j + 1) * D + c); else v = *(const f32x4*)(U2F + (size_t)(MP + b) * D + c);
        *(f32x4*)(out + O_PLS + ((size_t)b * 15 + j) * D + c) = v;
    }
}
struct Args { const float* in[N_IN]; float* out; unsigned char* ws; };
__global__ void __launch_bounds__(NTHREADS, 2) mega_fwd(Args args) {
    extern __shared__ __attribute__((aligned(16))) unsigned char lds_raw[];
    LAS unsigned char* lds = (LAS unsigned char*)lds_raw;
    const int tid = threadIdx.x, lane = tid & 63, wave = __builtin_amdgcn_readfirstlane(tid >> 6);
    const int G = gridDim.x, bx = blockIdx.x;
    const int vcu = (G % 8 == 0) ? (bx % 8) * (G / 8) + bx / 8 : bx;
    const int gw = vcu * NWAVES + wave, ngw = G * NWAVES;
    const size_t gt = (size_t)vcu * NTHREADS + tid, ngt = (size_t)G * NTHREADS;
    unsigned char* ws = args.ws; float* out = args.out;
    const float* const* in = args.in;
    gu32* ctl = (gu32*)(ws + WS_CTL);
    for (int u = tid; u < (LDS_BYTES - LDSCTL_OFF) / 4; u += NTHREADS) ((LAS unsigned*)(lds + LDSCTL_OFF))[u] = 0u;
    __syncthreads();
    volatile LAS unsigned* MISC = (volatile LAS unsigned*)(lds + MISC_OFF);
    XcdBarrier bar = xcd_barrier_post((unsigned*)(ctl + CW_BAR), MISC + 8);
    bf16* WIN = (bf16*)(ws + WS_WIN); bf16* WOUT = (bf16*)(ws + WS_WOUT); bf16* WPOOL = (bf16*)(ws + WS_WPOOL);
    bf16* U = (bf16*)(ws + WS_U); float* Gt = (float*)(ws + WS_G); bf16* XC = (bf16*)(ws + WS_XC); bf16* HY = (bf16*)(ws + WS_HY);
    bf16* PROJ = (bf16*)(ws + WS_PROJ); float* OUTF = (float*)(ws + WS_OUTF); bf16* HMID = (bf16*)(ws + WS_HMID); float* U2F = (float*)(ws + WS_U2F);
    float* Y = out + O_Y;
#define GEMM_PHASE(EPI, gA, gB, gN, gK, glda, gldb, gpn, epi) do { pg8::Gemm g_{gA, gB, MPAD, gN, gK, glda, gldb, gpn}; pg8::StaticOrder S_; S_.init(MPAD, gN, G, bx); \
        pg8::gemm_phase<EPI, pg8::StaticOrder, true, true>(lds + RING_OFF, g_, S_, epi); } while (0)

    prep_phase(in, ws, (LAS float*)(lds + RING_OFF + wave * 16384), gw, ngw, lane);
    norm0_phase(in[I_XP], in[I_XS], in[I_GMIXPRE], U, gw, ngw, lane);
    xcd_barrier(bar);
    GEMM_PHASE(pg8::EpiBf16, U, WIN, NIN, D, D, D, 0, (pg8::EpiBf16{PROJ, NIN, 0}));
    xcd_barrier(bar);
    conv_phase(PROJ, in[I_SCONV], in[I_CONVW], in[I_CONVB], in[I_BIG], in[I_BFG], in[I_DTBIAS], in[I_ALOG], XC, Gt, out, gt, ngt);
    xcd_barrier(bar);
    {
        const int half = tid >> 8, ht = tid & 255;
        if (vcu < 128) mlstm_prompt_naive(PROJ, Gt, HY, out, 2 * vcu + half, (LAS float*)(lds + RING_OFF) + half * MLN_LDS_F, ht);
        else if (vcu < 192) ssd_prompt_naive(XC, Gt, in[I_DSKIP], HY, out, 2 * (vcu - 128) + half, (LAS float*)(lds + RING_OFF) + half * SSN_LDS_F, ht);
        else {
            const int hb = (vcu - 192) * 2 + half, nhb = (G - 192) * 2;
            for (int it = hb; it < MS * MH; it += nhb) mlstm_sample_item(PROJ, Gt, in[I_SC], in[I_SN], in[I_SM], HY, out, it, (LAS float*)(lds + RING_OFF) + half * 2048, ht);
            for (int it = hb; it < MS * SH; it += nhb) ssd_sample_item(XC, Gt, in[I_DSKIP], in[I_SSSM], HY, out, it, ht);
        }
    }
    xcd_barrier(bar);
    finish_phase(PROJ, in[I_GMLSTM], in[I_GSSM], HY, gw, ngw, lane);
    xcd_barrier(bar);
    GEMM_PHASE(pg8::EpiF32, HY, WOUT, D, MIX, MIX, MIX, 0, (pg8::EpiF32{OUTF, D, 0}));
    xcd_barrier(bar);
    rowpass_phase(in[I_XP], in[I_XS], nullptr, OUTF, in[I_GMIXPOST], in[I_GFFNPRE], Y, U, nullptr, gw, ngw, lane);
    xcd_barrier(bar);
    GEMM_PHASE(pg8::EpiSwiGLU, U, (bf16*)(ws + WS_WGU), NGU, D, D, D, 0, (pg8::EpiSwiGLU{HMID, FF, 0}));
    xcd_barrier(bar);
    GEMM_PHASE(pg8::EpiF32, HMID, (bf16*)(ws + WS_WDN), D, FF, FF, FF, 0, (pg8::EpiF32{OUTF, D, 0}));
    xcd_barrier(bar);
    rowpass_phase(in[I_XP], in[I_XS], Y, OUTF, in[I_GFFNPOST], in[I_GMIXPRE] + D, Y, nullptr, U2F, gw, ngw, lane);
    xcd_barrier(bar);
    pool_phase(U2F, in[I_SPOOL], U, out, gt, ngt);
    xcd_barrier(bar);
    GEMM_PHASE(pg8::EpiF32, U, WPOOL, D, 256, D, 256, 256, (pg8::EpiF32{OUTF, D, 0}));
    xcd_barrier(bar);
    rowpass_phase(in[I_XP], in[I_XS], Y, OUTF, in[I_GMIXPOST] + D, in[I_GFFNPRE] + D, Y, U, nullptr, gw, ngw, lane);
    xcd_barrier(bar);
    GEMM_PHASE(pg8::EpiSwiGLU, U, (bf16*)(ws + WS_WGU + al((size_t)NGU * D * 2)), NGU, D, D, D, 0, (pg8::EpiSwiGLU{HMID, FF, 0}));
    xcd_barrier(bar);
    GEMM_PHASE(pg8::EpiF32, HMID, (bf16*)(ws + WS_WDN + al((size_t)D * FF * 2)), D, FF, FF, FF, 0, (pg8::EpiF32{OUTF, D, 0}));
    xcd_barrier(bar);
    rowpass_phase(in[I_XP], in[I_XS], Y, OUTF, in[I_GFFNPOST] + D, nullptr, Y, nullptr, nullptr, gw, ngw, lane);
#undef GEMM_PHASE
}

extern "C" void kernel_launch(void* const* d_in, const int* in_sizes, int n_in, void* d_out, int out_size, void* d_ws, size_t ws_size, hipStream_t stream) {
    static int grid = 0;
    if (grid == 0) {
        if (n_in != N_IN || (size_t)out_size != O_END || ws_size < WS_END) {
            fprintf(stderr, "kernel_launch: unexpected sizes n_in %d out %d ws %zu (need %zu)\n", n_in, out_size, ws_size, (size_t)WS_END); grid = -1; return; }
        int dev = 0, cus = 0, per_cu = 0;
        if (hipGetDevice(&dev) != hipSuccess || hipDeviceGetAttribute(&cus, hipDeviceAttributeMultiprocessorCount, dev) != hipSuccess) { grid = -1; return; }
        if (hipFuncSetAttribute((const void*)mega_fwd, hipFuncAttributeMaxDynamicSharedMemorySize, LDS_BYTES) != hipSuccess) { fprintf(stderr, "kernel_launch: hipFuncSetAttribute failed\n"); grid = -1; return; }
        if (hipOccupancyMaxActiveBlocksPerMultiprocessor(&per_cu, (const void*)mega_fwd, NTHREADS, LDS_BYTES) != hipSuccess || per_cu < 1) {
            fprintf(stderr, "kernel_launch: occupancy query says %d blocks per CU; need 1\n", per_cu); grid = -1; (void)hipGetLastError(); return; }
        grid = cus;
        if (grid != 256) fprintf(stderr, "kernel_launch: note: %d CUs (tuned for 256)\n", grid);
    }
    if (grid < 0) return;
    (void)hipMemsetAsync((char*)d_ws + cfg::WS_CTL, 0, CTL_ZERO_BYTES, stream);
    Args a; memset(&a, 0, sizeof(a));
    for (int i = 0; i < N_IN; ++i) a.in[i] = (const float*)d_in[i];
    a.out = (float*)d_out; a.ws = (unsigned char*)d_ws;
    void* kargs[] = {&a};
    hipError_t e = hipLaunchCooperativeKernel((const void*)mega_fwd, dim3(grid), dim3(NTHREADS), kargs, LDS_BYTES, stream);
    if (e != hipSuccess) fprintf(stderr, "kernel_launch: cooperative launch failed: %s (grid %d)\n", hipGetErrorString(e), grid);
}
```

```cpp
#include <hip/hip_runtime.h>
#include <cstdio>
#include <cstring>
#include <cstdint>
namespace pg8 {
#define PG8_LAS __attribute__((address_space(3)))
typedef unsigned short bf16_t;
typedef short bf16x8 __attribute__((ext_vector_type(8)));
typedef float f32x4 __attribute__((ext_vector_type(4)));
typedef float f32x2 __attribute__((ext_vector_type(2)));
typedef unsigned u32x4 __attribute__((ext_vector_type(4)));
constexpr int BM = 256, BK = 64, HALF = 128, HTB = HALF * BK * 2  , STAGE_BYTES = 8 * HTB, NXCD = 8, WGM = 8;

__host__ __device__ __forceinline__ int lds_byte(int r, int c) { const int st = (r >> 4) * 2 + (c >> 5), rr = r & 15, cc = c & 31, ob = rr * 64 + cc * 2; return st * 1024 + (ob ^ (((ob >> 9) & 1) << 5)); }
__host__ __device__ __forceinline__ void stage_rc(int b, int& R, int& C) { const int st = b / 1024, sb = b % 1024, swz = sb ^ (((sb >> 9) & 1) << 5); R = (st >> 1) * 16 + swz / 64; C = (st & 1) * 32 + (swz % 64) / 2; }
__host__ __device__ __forceinline__ int perm32(int rho) { const int n = rho >> 4, i = rho & 15; return 8 * (i >> 2) + 4 * n + (i & 3); }

struct Unit { int pm, pn; };
struct Gemm { const bf16_t* A; const bf16_t* Bt; int M, N, K, lda, ldb, a_pn_off; };

struct StaticOrder {
    int nM, nN, nwg, G, c;
    __host__ __device__ void init(int M, int N, int G_, int c_) { nM = M / BM; nN = N / BM; nwg = nM * nN; G = G_; c = c_; }
    __host__ __device__ bool next(int i, Unit& u) const {
        const long L = (long)i * G + c; if (L >= nwg) return false;
        int wgid = (int)L; { const int q = nwg / NXCD, r = nwg % NXCD, xcd = wgid % NXCD, off = wgid / NXCD; wgid = (xcd < r ? xcd * (q + 1) : r * (q + 1) + (xcd - r) * q) + off; }
        const int nig = WGM * nN, gid = wgid / nig, fm = gid * WGM, gsz = (nM - fm) < WGM ? (nM - fm) : WGM;
        u.pm = fm + ((wgid % nig) % gsz); u.pn = (wgid % nig) / gsz; return true;
    }
    __device__ __forceinline__ void a_ready(const Unit&) const {}
    __device__ __forceinline__ void done(const Unit&) const {}
};

__device__ __forceinline__ unsigned cvt_pk_bf16(float lo, float hi) { unsigned r; asm volatile("v_cvt_pk_bf16_f32 %0, %1, %2" : "=v"(r) : "v"(lo), "v"(hi)); return r; }

struct EpiF32 {
    static constexpr bool PERM = false, AFTER_DRAIN = false;
    float* C; int ldc, pad;
    __device__ __forceinline__ void operator()(const f32x4 (&acc)[2][2][4][2], const Unit& u, int wr, int wc, int fr, int fq) const {
        const int row0 = u.pm * BM + wr * 64 + fr, col0 = u.pn * BM + wc * 32 + 4 * fq;
#pragma unroll
        for (int ai = 0; ai < 2; ++ai)
#pragma unroll
            for (int m = 0; m < 4; ++m) { float* rowp = C + (size_t)(row0 + ai * HALF + m * 16) * ldc + col0;
#pragma unroll
                for (int bj = 0; bj < 2; ++bj)
#pragma unroll
                    for (int n = 0; n < 2; ++n) *(f32x4*)(rowp + bj * HALF + n * 16) = acc[ai][bj][m][n]; }
    }
};
struct EpiBf16 {
    static constexpr bool PERM = true, AFTER_DRAIN = false;
    bf16_t* O; int ldc, pad;
    __device__ __forceinline__ void operator()(const f32x4 (&acc)[2][2][4][2], const Unit& u, int wr, int wc, int fr, int fq) const {
        const int row0 = u.pm * BM + wr * 64 + fr; const int col0 = u.pn * BM + wc * 32 + 8 * fq;
#pragma unroll
        for (int ai = 0; ai < 2; ++ai)
#pragma unroll
            for (int m = 0; m < 4; ++m) { bf16_t* rowp = O + (size_t)(row0 + ai * HALF + m * 16) * ldc + col0;
#pragma unroll
                for (int bj = 0; bj < 2; ++bj) { const f32x4 v0 = acc[ai][bj][m][0], v1 = acc[ai][bj][m][1];
                    u32x4 w; w.x = cvt_pk_bf16(v0[0], v0[1]); w.y = cvt_pk_bf16(v0[2], v0[3]); w.z = cvt_pk_bf16(v1[0], v1[1]); w.w = cvt_pk_bf16(v1[2], v1[3]);
                    *(u32x4*)(rowp + bj * HALF) = w; } }
    }
};
__device__ __forceinline__ float silu_f(float x) { return x * __builtin_amdgcn_rcpf(1.0f + __expf(-x)); }
struct EpiSwiGLU {
    static constexpr bool PERM = true, AFTER_DRAIN = false;
    bf16_t* O; int ldc, pad;
    __device__ __forceinline__ void operator()(const f32x4 (&acc)[2][2][4][2], const Unit& u, int wr, int wc, int fr, int fq) const {
        const int row0 = u.pm * BM + wr * 64 + fr; const int col0 = u.pn * HALF + wc * 32 + 8 * fq;
#pragma unroll
        for (int ai = 0; ai < 2; ++ai)
#pragma unroll
            for (int m = 0; m < 4; ++m) { bf16_t* rowp = O + (size_t)(row0 + ai * HALF + m * 16) * ldc + col0;
                const f32x4 g0 = acc[ai][0][m][0], g1 = acc[ai][0][m][1], u0 = acc[ai][1][m][0], u1 = acc[ai][1][m][1];
                float h[8];
#pragma unroll
                for (int j = 0; j < 4; ++j) { h[j] = silu_f(g0[j]) * u0[j]; h[4 + j] = silu_f(g1[j]) * u1[j]; }
                u32x4 w; w.x = cvt_pk_bf16(h[0], h[1]); w.y = cvt_pk_bf16(h[2], h[3]); w.z = cvt_pk_bf16(h[4], h[5]); w.w = cvt_pk_bf16(h[6], h[7]);
                *(u32x4*)rowp = w; }
    }
};

template <class Epi, class Sched, bool ALIGN_EPI = false, bool SP2 = false>
__device__ __forceinline__ void gemm_phase(PG8_LAS unsigned char* lds, const Gemm g, const Sched& S, const Epi& E) {
    const int tid = threadIdx.x, wid = __builtin_amdgcn_readfirstlane(tid >> 6), lane = tid & 63, wr = wid >> 2, wc = wid & 3, fr = lane & 15, fq = lane >> 4;
    const int K = g.K, nt = K / BK;
    unsigned voffA[2], voffB[2];
#pragma unroll
    for (int i = 0; i < 2; ++i) { int R, C; stage_rc(tid * 16 + i * 8192, R, C); const int Rb = Epi::PERM ? ((R & ~31) + perm32(R & 31)) : R;
        voffA[i] = (unsigned)(R * g.lda + C) * 2u; voffB[i] = (unsigned)(Rb * g.ldb + C) * 2u; }
    const size_t kstep = (size_t)(BK * 2);
    const size_t hstepA = (size_t)HALF * g.lda * 2, hstepB = (size_t)HALF * g.ldb * 2;
    const size_t tstepA = 2 * hstepA, tstepB = 2 * hstepB;
    const size_t pnoffA = (size_t)g.a_pn_off * 2;
    const unsigned ldsw = (unsigned)wid * 1024u;
    const int aoff = lds_byte(wr * 64 + fr, fq * 8), boff = lds_byte(wc * 32 + fr, fq * 8);
#define PG8_SA(b, h) (((b) * 2 + (h)) * HTB)
#define PG8_SB(b, h) ((4 + (b) * 2 + (h)) * HTB)
#define PG8_STAGE(bufoff, gbase, voff) do { _Pragma("unroll") for (int _i = 0; _i < 2; ++_i) \
        __builtin_amdgcn_global_load_lds((const unsigned*)((const char*)(gbase) + (voff)[_i]), (PG8_LAS unsigned*)(lds + (bufoff) + ldsw + _i * 8192), 16, 0, 0); } while (0)
#define PG8_LDA(dst, b, h) do { _Pragma("unroll") for (int m = 0; m < 4; ++m) _Pragma("unroll") for (int k = 0; k < 2; ++k) dst[m][k] = *(const PG8_LAS bf16x8*)(lds + PG8_SA(b, h) + aoff + m * 2048 + k * 1024); } while (0)
#define PG8_LDB(dst, b, h) do { _Pragma("unroll") for (int n = 0; n < 2; ++n) _Pragma("unroll") for (int k = 0; k < 2; ++k) dst[n][k] = *(const PG8_LAS bf16x8*)(lds + PG8_SB(b, h) + boff + n * 2048 + k * 1024); } while (0)
#define PG8_MMA(ai, bj, At, Bt) do { __builtin_amdgcn_s_setprio(1); _Pragma("unroll") for (int m = 0; m < 4; ++m) _Pragma("unroll") for (int n = 0; n < 2; ++n) _Pragma("unroll") for (int k = 0; k < 2; ++k) \
        acc[ai][bj][m][n] = __builtin_amdgcn_mfma_f32_16x16x32_bf16(Bt[n][k], At[m][k], acc[ai][bj][m][n], 0, 0, 0); __builtin_amdgcn_s_setprio(0); } while (0)
#define PG8_WAIT_V(n) asm volatile("s_waitcnt vmcnt(" #n ")" ::: "memory")
#define PG8_WAIT_L(n) asm volatile("s_waitcnt lgkmcnt(" #n ")" ::: "memory")
#define PG8_BAR __builtin_amdgcn_s_barrier()
#define PG8_SCHED __builtin_amdgcn_sched_barrier(0)
    Unit cur, nxt; int ui = 0;
    if (!S.next(0, cur)) return;
    f32x4 acc[2][2][4][2];
#pragma unroll
    for (int a = 0; a < 2; ++a)
#pragma unroll
        for (int b = 0; b < 2; ++b)
#pragma unroll
            for (int m = 0; m < 4; ++m)
#pragma unroll
                for (int n = 0; n < 2; ++n) acc[a][b][m][n] = (f32x4){0.f, 0.f, 0.f, 0.f};
    bf16x8 At[4][2], B0[2][2], B1[2][2];
    const char* cA = (const char*)g.A + (size_t)cur.pm * tstepA + (size_t)cur.pn * pnoffA; const char* cB = (const char*)g.Bt + (size_t)cur.pn * tstepB;
    S.a_ready(cur);
    if constexpr (SP2) {
        PG8_STAGE(PG8_SB(0, 0), cB, voffB); PG8_STAGE(PG8_SB(0, 1), cB + hstepB, voffB); PG8_STAGE(PG8_SA(0, 0), cA, voffA); PG8_STAGE(PG8_SA(0, 1), cA + hstepA, voffA);
        if (wr == 1) PG8_BAR;
        PG8_WAIT_V(2); PG8_BAR;
        PG8_STAGE(PG8_SB(1, 0), cB + kstep, voffB); PG8_STAGE(PG8_SA(1, 0), cA + kstep, voffA); PG8_STAGE(PG8_SB(1, 1), cB + hstepB + kstep, voffB);
        PG8_WAIT_V(6); PG8_BAR;
    } else {
        PG8_STAGE(PG8_SB(0, 0), cB, voffB); PG8_STAGE(PG8_SA(0, 0), cA, voffA); PG8_STAGE(PG8_SB(0, 1), cB + hstepB, voffB); PG8_STAGE(PG8_SA(0, 1), cA + hstepA, voffA);
        if (wr == 1) PG8_BAR;
        PG8_WAIT_V(4); PG8_BAR;
        PG8_STAGE(PG8_SB(1, 0), cB + kstep, voffB); PG8_STAGE(PG8_SA(1, 0), cA + kstep, voffA); PG8_STAGE(PG8_SB(1, 1), cB + hstepB + kstep, voffB);
        PG8_WAIT_V(6); PG8_BAR;
    }
    for (;;) {
        const bool has_next = S.next(ui + 1, nxt);
        const char* nA = has_next ? (const char*)g.A + (size_t)nxt.pm * tstepA + (size_t)nxt.pn * pnoffA : cA; const char* nB = has_next ? (const char*)g.Bt + (size_t)nxt.pn * tstepB : cB;
        for (int t = 0; t < nt; t += 2) {
            const bool last = (t == nt - 2);
            const char* a1 = cA + (size_t)(t + 1) * kstep;
            const char* a2 = last ? nA : cA + (size_t)(t + 2) * kstep; const char* b2 = last ? nB : cB + (size_t)(t + 2) * kstep;
            const char* a3 = a2 + kstep; const char* b3 = b2 + kstep;
            if (last && has_next) S.a_ready(nxt);
            if constexpr (SP2) {
            PG8_LDB(B0, 0, 0); PG8_LDB(B1, 0, 1); PG8_SCHED; PG8_LDA(At, 0, 0); PG8_STAGE(PG8_SA(1, 1), a1 + hstepA, voffA);
            PG8_WAIT_V(8); PG8_WAIT_L(0); PG8_BAR; PG8_MMA(0, 0, At, B0); PG8_MMA(0, 1, At, B1); PG8_BAR; PG8_SCHED;
            PG8_LDA(At, 0, 1); PG8_STAGE(PG8_SB(0, 0), b2, voffB); PG8_STAGE(PG8_SB(0, 1), b2 + hstepB, voffB); PG8_STAGE(PG8_SA(0, 0), a2, voffA);
            PG8_WAIT_V(8); PG8_WAIT_L(0); PG8_BAR; PG8_MMA(1, 0, At, B0); PG8_MMA(1, 1, At, B1); PG8_BAR; PG8_SCHED;
            PG8_LDB(B0, 1, 0); PG8_LDB(B1, 1, 1); PG8_SCHED; PG8_LDA(At, 1, 0); PG8_STAGE(PG8_SA(0, 1), a2 + hstepA, voffA);
            PG8_WAIT_V(8); PG8_WAIT_L(0); PG8_BAR; PG8_MMA(0, 0, At, B0); PG8_MMA(0, 1, At, B1); PG8_BAR; PG8_SCHED;
            PG8_LDA(At, 1, 1); PG8_STAGE(PG8_SB(1, 0), b3, voffB); PG8_STAGE(PG8_SB(1, 1), b3 + hstepB, voffB); PG8_STAGE(PG8_SA(1, 0), a3, voffA);
            PG8_WAIT_V(8); PG8_WAIT_L(0); PG8_BAR; PG8_MMA(1, 0, At, B0); PG8_MMA(1, 1, At, B1); PG8_BAR; PG8_SCHED;
            } else {
            PG8_LDB(B0, 0, 0); PG8_SCHED; PG8_LDA(At, 0, 0); PG8_STAGE(PG8_SA(1, 1), a1 + hstepA, voffA);
            PG8_WAIT_L(8); PG8_BAR; PG8_WAIT_L(0); PG8_MMA(0, 0, At, B0); PG8_BAR; PG8_SCHED;
            PG8_LDB(B1, 0, 1); PG8_STAGE(PG8_SB(0, 0), b2, voffB);
            PG8_BAR; PG8_WAIT_L(0); PG8_MMA(0, 1, At, B1); PG8_BAR;
            PG8_LDA(At, 0, 1); PG8_STAGE(PG8_SA(0, 0), a2, voffA);
            PG8_BAR; PG8_WAIT_L(0); PG8_MMA(1, 0, At, B0); PG8_BAR; PG8_SCHED;
            PG8_STAGE(PG8_SB(0, 1), b2 + hstepB, voffB);
            PG8_WAIT_V(6); PG8_BAR; PG8_MMA(1, 1, At, B1); PG8_BAR;
            PG8_LDB(B0, 1, 0); PG8_SCHED; PG8_LDA(At, 1, 0); PG8_STAGE(PG8_SA(0, 1), a2 + hstepA, voffA);
            PG8_WAIT_L(8); PG8_BAR; PG8_WAIT_L(0); PG8_MMA(0, 0, At, B0); PG8_BAR; PG8_SCHED;
            PG8_LDB(B1, 1, 1); PG8_STAGE(PG8_SB(1, 0), b3, voffB);
            PG8_BAR; PG8_WAIT_L(0); PG8_MMA(0, 1, At, B1); PG8_BAR;
            PG8_LDA(At, 1, 1); PG8_STAGE(PG8_SA(1, 0), a3, voffA);
            PG8_BAR; PG8_WAIT_L(0); PG8_MMA(1, 0, At, B0); PG8_BAR; PG8_SCHED;
            PG8_STAGE(PG8_SB(1, 1), b3 + hstepB, voffB);
            PG8_WAIT_V(6); PG8_BAR; PG8_MMA(1, 1, At, B1); PG8_BAR;
            }
        }
        if constexpr (ALIGN_EPI) { if (wr == 0) PG8_BAR; }
        if constexpr (!Epi::AFTER_DRAIN) { E(acc, cur, wr, wc, fr, fq); S.done(cur); }
        if (!has_next) break;
#pragma unroll
        for (int a = 0; a < 2; ++a)
#pragma unroll
            for (int b = 0; b < 2; ++b)
#pragma unroll
                for (int m = 0; m < 4; ++m)
#pragma unroll
                    for (int n = 0; n < 2; ++n) acc[a][b][m][n] = (f32x4){0.f, 0.f, 0.f, 0.f};
        cur = nxt; cA = nA; cB = nB; ++ui;
        if constexpr (ALIGN_EPI) { if (wr == 1) PG8_BAR; }
    }
    PG8_WAIT_V(0);
    if constexpr (!ALIGN_EPI) { if (wr == 0) PG8_BAR; }
    PG8_BAR;
    if constexpr (Epi::AFTER_DRAIN) { E.fused(acc, cur, wr, wc, fr, fq, lds, wid, lane); S.done(cur); }
#undef PG8_SA
#undef PG8_SB
#undef PG8_STAGE
#undef PG8_LDA
#undef PG8_LDB
#undef PG8_MMA
#undef PG8_WAIT_V
#undef PG8_WAIT_L
#undef PG8_BAR
#undef PG8_SCHED
}
}
namespace cfg {
constexpr int D = 1024, BATCH = 8, SEQ = 2048, MP = BATCH * SEQ, MS = 128, MR = MP + MS, MPAD = 16640;
constexpr int MH = 4, MDK = 256, MDV = 256;
constexpr int SH = 16, SP = 64, SG = 2, SN = 128, CONVD = 1536;
constexpr int INDIM = 6680, NIN = 6912, FF = 2816, NGU = 2 * FF, MIX = 2048;
constexpr float EPS = 1e-6f, GATE_CAP = 15.0f;
constexpr int PQ = 0, PK = 1024, PV = 2048, PO = 3072, PZ = 4096, PX = 5120, PG = 6656;
constexpr int GW = 40;
enum { I_XP = 0, I_XS, I_SC, I_SN, I_SM, I_SSSM, I_SCONV, I_SPOOL, I_GMIXPRE, I_GMIXPOST, I_GFFNPRE, I_GFFNPOST, I_WIN, I_BIG, I_BFG, I_GMLSTM,
       I_CONVW, I_CONVB, I_DTBIAS, I_ALOG, I_DSKIP, I_GSSM, I_WOUT, I_WPOOL, I_POOLSCALE, I_WGATE, I_WUP, I_WDOWN, N_IN };
constexpr size_t O_Y = 0;
constexpr size_t O_CP = O_Y + (size_t)MR * D;
constexpr size_t O_CS = O_CP + (size_t)BATCH * MH * MDK * MDV;
constexpr size_t O_NP = O_CS + (size_t)MS * MH * MDK * MDV;
constexpr size_t O_NS = O_NP + (size_t)BATCH * MH * MDK;
constexpr size_t O_MP = O_NS + (size_t)MS * MH * MDK;
constexpr size_t O_MS = O_MP + (size_t)BATCH * MH;
constexpr size_t O_SSP = O_MS + (size_t)MS * MH;
constexpr size_t O_SSS = O_SSP + (size_t)BATCH * SH * SP * SN;
constexpr size_t O_CVP = O_SSS + (size_t)MS * SH * SP * SN;
constexpr size_t O_CVS = O_CVP + (size_t)BATCH * 3 * CONVD;
constexpr size_t O_PLP = O_CVS + (size_t)MS * 3 * CONVD;
constexpr size_t O_PLS = O_PLP + (size_t)BATCH * 15 * D;
constexpr size_t O_END = O_PLS + (size_t)MS * 15 * D;
static_assert(O_END == 73241120, "output size");
constexpr size_t al(size_t x) { return (x + 4095) & ~(size_t)4095; }
constexpr size_t WS_CTL = 0, CTL_BYTES = 1u << 20;
constexpr size_t WS_WIN = WS_CTL + CTL_BYTES;
constexpr size_t WS_WOUT = WS_WIN + al((size_t)NIN * D * 2);
constexpr size_t WS_WGU = WS_WOUT + al((size_t)D * MIX * 2);
constexpr size_t WS_WDN = WS_WGU + 2 * al((size_t)NGU * D * 2);
constexpr size_t WS_WPOOL = WS_WDN + 2 * al((size_t)D * FF * 2);
constexpr size_t WS_U = WS_WPOOL + al((size_t)D * 256 * 2);
constexpr size_t WS_G = WS_U + al((size_t)MPAD * D * 2);
constexpr size_t WS_XC = WS_G + al((size_t)MR * GW * 4);
constexpr size_t WS_HY = WS_XC + al((size_t)MR * CONVD * 2);
constexpr size_t WS_PROJ = WS_HY + al((size_t)MPAD * MIX * 2);
constexpr size_t WS_OUTF = WS_PROJ;
constexpr size_t WS_HMID = WS_OUTF + al((size_t)MPAD * D * 4);
constexpr size_t WS_U2F = WS_HMID + al((size_t)MPAD * FF * 2);
constexpr size_t WS_END0 = WS_PROJ + al((size_t)MPAD * NIN * 2);
constexpr size_t WS_END1 = WS_U2F + al((size_t)MR * D * 4);
constexpr size_t WS_END = WS_END0 > WS_END1 ? WS_END0 : WS_END1;
}

typedef unsigned short bf16;
#define LAS __attribute__((address_space(3)))
typedef float f32x4 __attribute__((ext_vector_type(4)));
typedef unsigned u32x4 __attribute__((ext_vector_type(4)));
typedef unsigned u32x2 __attribute__((ext_vector_type(2)));

__device__ __forceinline__ unsigned f2bf(float f) { unsigned u = __builtin_bit_cast(unsigned, f); return (u + 0x7fffu + ((u >> 16) & 1u)) >> 16; }
__device__ __forceinline__ unsigned pk2(float lo, float hi) { return f2bf(lo) | (f2bf(hi) << 16); }
__device__ __forceinline__ float bf2f(unsigned short b) { return __builtin_bit_cast(float, (unsigned)b << 16); }
__device__ __forceinline__ float bflo(unsigned w) { return __builtin_bit_cast(float, w << 16); }
__device__ __forceinline__ float bfhi(unsigned w) { return __builtin_bit_cast(float, w & 0xffff0000u); }
__device__ __forceinline__ f32x4 ld_bf4(const bf16* p) { const u32x2 w = *(const u32x2*)p; return (f32x4){bflo(w.x), bfhi(w.x), bflo(w.y), bfhi(w.y)}; }
__device__ __forceinline__ void st_bf4(bf16* p, f32x4 v) { u32x2 w; w.x = pk2(v.x, v.y); w.y = pk2(v.z, v.w); *(u32x2*)p = w; }
__device__ __forceinline__ float wave_sum(float v) {
#pragma unroll
    for (int o = 1; o < 64; o <<= 1) v += __shfl_xor(v, o);
    return v;
}
__device__ __forceinline__ float sigmoid_f(float x) { return 1.0f / (1.0f + expf(-x)); }
__device__ __forceinline__ float silu_x(float x) { return x / (1.0f + expf(-x)); }
__device__ __forceinline__ float softplus_f(float x) { return fmaxf(x, 0.f) + log1pf(expf(-fabsf(x))); }
__device__ __forceinline__ float softcap_f(float x) { return cfg::GATE_CAP * tanhf(x * (1.0f / cfg::GATE_CAP)); }
constexpr int NWAVES = 8, NTHREADS = NWAVES * 64;
constexpr int RING_OFF = 0, RING_BYTES = 139264;
constexpr int LDSCTL_OFF = RING_BYTES, MISC_OFF = LDSCTL_OFF + 320;
constexpr int LDS_BYTES = 147456;
constexpr int CW_TMO = 0, CW_CODE = 1, CW_BAR = 4096, CTL_ZERO_BYTES = 65536;
#define GAS __attribute__((address_space(1)))
typedef GAS unsigned gu32;
#define RLX_AGENT __ATOMIC_RELAXED, __HIP_MEMORY_SCOPE_AGENT

#define XB_TMO      128
#define XB_XCNT(j)  (256  + 64 * (j))
#define XB_XSUB(j)  (1280 + 64 * (j))
#define XB_XGEN(j)  (2304 + 64 * (j))
#define XB_TOP      3328
#define XB_TOPGEN   3392
#define XCD_BAR_WORDS 3456
#define XB_SPIN_CAP (1u << 22)
static_assert((CW_BAR + XCD_BAR_WORDS) * 4 <= CTL_ZERO_BYTES, "barrier words inside the memset region");

__device__ __forceinline__ unsigned xb_ld(unsigned* p)              { return __hip_atomic_load(p, __ATOMIC_RELAXED, __HIP_MEMORY_SCOPE_AGENT); }
__device__ __forceinline__ unsigned xb_add(unsigned* p, unsigned v) { return __hip_atomic_fetch_add(p, v, __ATOMIC_RELAXED, __HIP_MEMORY_SCOPE_AGENT); }
__device__ __forceinline__ unsigned xb_xcc_id() { return (unsigned)__builtin_amdgcn_s_getreg((3 << 11) | 20) & 0xFu; }
#define XB_SPIN(cond, bar) do { unsigned _sp = 0; while (cond) { __builtin_amdgcn_s_sleep(1); \
    if ((++_sp & 255u) == 0u) { if (xb_ld(&(bar)[XB_TMO])) break; if (_sp > XB_SPIN_CAP) { atomicAdd(&(bar)[XB_TMO], 1u); break; } } } } while (0)

struct XcdBarrier {
    unsigned* bar; unsigned x;
    volatile LAS unsigned* st;
};
__device__ __forceinline__ XcdBarrier xcd_barrier_post(unsigned* bar, volatile LAS unsigned* st) {
    XcdBarrier b; b.bar = bar; b.x = xb_xcc_id(); b.st = st;
    if (threadIdx.x == 0) (void)xb_add(&bar[XB_XCNT(b.x)], 1u);
    return b;
}
__device__ __forceinline__ void xcd_barrier_complete(unsigned* bar, unsigned x, unsigned& nloc, unsigned& nx) {
    const unsigned G = gridDim.x * gridDim.y * gridDim.z;
    unsigned sum, cnt, mine, sp = 0u;
    for (;;) {
        sum = 0u; cnt = 0u; mine = 0u;
#pragma unroll
        for (unsigned j = 0; j < 16; ++j) { const unsigned c = xb_ld(&bar[XB_XCNT(j)]); sum += c; cnt += (c > 0u) ? 1u : 0u; mine = (j == x) ? c : mine; }
        if (sum == G) break;
        __builtin_amdgcn_s_sleep(1);
        if ((++sp & 255u) == 0u) { if (xb_ld(&bar[XB_TMO])) break; if (sp > XB_SPIN_CAP) { atomicAdd(&bar[XB_TMO], 1u); break; } }
    }
    nloc = mine > 0u ? mine : 1u; nx = cnt > 0u ? cnt : 1u;
}
__device__ __forceinline__ void xcd_barrier(const XcdBarrier& b) {
    asm volatile("s_waitcnt vmcnt(0)" ::: "memory");
    __syncthreads();
    if (threadIdx.x == 0) {
        unsigned* bar = b.bar;
        __builtin_amdgcn_s_waitcnt(0);
        unsigned nloc = b.st[0], nx = b.st[1];
        if (nloc == 0u) { xcd_barrier_complete(bar, b.x, nloc, nx); b.st[0] = nloc; b.st[1] = nx; }
        const unsigned old = xb_add(&bar[XB_XSUB(b.x)], 1u);
        const unsigned gen = old / nloc;
        if (old + 1u == (gen + 1u) * nloc) {
            __builtin_amdgcn_fence(__ATOMIC_RELEASE, "agent");
            asm volatile("s_waitcnt vmcnt(0)" ::: "memory");
            const unsigned og = xb_add(&bar[XB_TOP], 1u);
            const unsigned tg = og / nx;
            if (og + 1u == (tg + 1u) * nx) xb_add(&bar[XB_TOPGEN], 1u);
            else XB_SPIN(xb_ld(&bar[XB_TOPGEN]) == tg, bar);
            __builtin_amdgcn_fence(__ATOMIC_ACQUIRE, "agent");
            xb_add(&bar[XB_XGEN(b.x)], 1u);
            asm volatile("s_waitcnt vmcnt(0)" ::: "memory");
        } else {
            XB_SPIN(xb_ld(&bar[XB_XGEN(b.x)]) == gen, bar);
            __builtin_amdgcn_fence(__ATOMIC_ACQUIRE, "agent");
            asm volatile("s_waitcnt vmcnt(0)" ::: "memory");
        }
    }
    __syncthreads();
}
using namespace cfg;
struct PrepMat { const float* W0; const float* W1; const float* scale; bf16* WT; int ldw, K, N, mode, nitems, pad; };
__device__ __forceinline__ void prep_item(const PrepMat& P, int item, LAS float* scr, int lane) {
    const int nblk = P.N / 32, kb = item / nblk, nb = item % nblk, k0 = 64 * kb, n0 = 32 * nb;
    const int n = n0 + (lane & 31);
    const float* W = P.W0; int sc = n; float mul = 1.0f;
    if (P.mode == 1) {
        if (n < 4096) { sc = n; if (n < 1024) mul = 0.0625f; }
        else if (n < 5120) sc = 4104 + (n - 4096);
        else if (n < 6656) sc = 5128 + (n - 5120);
        else if (n < 6664) sc = 4096 + (n - 6656);
        else if (n < 6680) sc = n;
        else sc = -1;
    } else if (P.mode == 2) {
        const int pn = n >> 8, w = n & 255; W = (w < 128) ? P.W0 : P.W1; sc = 128 * pn + (w & 127);
    } else if (P.mode == 3) {
        mul = P.scale[n];
    }
#pragma unroll 8
    for (int i = 0; i < 32; ++i) { const int kk = 2 * i + (lane >> 5); scr[kk * 33 + (lane & 31)] = (sc >= 0) ? W[(size_t)(k0 + kk) * P.ldw + sc] * mul : 0.f; }
    asm volatile("s_waitcnt lgkmcnt(0)" ::: "memory");
    const int c = lane & 7;
#pragma unroll
    for (int j = 0; j < 4; ++j) { const int nn = (lane >> 3) + 8 * j; const LAS float* s = scr + (8 * c) * 33 + nn;
        u32x4 o; o.x = pk2(s[0 * 33], s[1 * 33]); o.y = pk2(s[2 * 33], s[3 * 33]); o.z = pk2(s[4 * 33], s[5 * 33]); o.w = pk2(s[6 * 33], s[7 * 33]);
        *(u32x4*)(P.WT + (size_t)(n0 + nn) * P.K + k0 + 8 * c) = o; }
    asm volatile("s_waitcnt lgkmcnt(0)" ::: "memory");
}
__device__ __forceinline__ PrepMat mk_mat(const float* W0, const float* W1, const float* scale, int ldw, int K, int N, int mode, bf16* WT) {
    PrepMat m; m.W0 = W0; m.W1 = W1; m.scale = scale; m.WT = WT; m.ldw = ldw; m.K = K; m.N = N; m.mode = mode; m.nitems = (K / 64) * (N / 32); m.pad = 0; return m;
}
constexpr int PI_IN = (D / 64) * (NIN / 32), PI_OUT = (MIX / 64) * (D / 32), PI_GU = (D / 64) * (NGU / 32), PI_DN = (FF / 64) * (D / 32), PI_PL = (256 / 64) * (256 / 32);
constexpr int PI_TOTAL = PI_IN + PI_OUT + 2 * PI_GU + 2 * PI_DN + 4 * PI_PL;
__device__ __forceinline__ void prep_phase(const float* const* in, unsigned char* ws, LAS float* scr, int gw, int ngw, int lane) {
    for (int it = gw; it < PI_TOTAL; it += ngw) {
        int r = it; PrepMat m;
        if (r < PI_IN) m = mk_mat(in[I_WIN], nullptr, nullptr, INDIM, D, NIN, 1, (bf16*)(ws + WS_WIN));
        else if ((r -= PI_IN) < PI_OUT) m = mk_mat(in[I_WOUT], nullptr, nullptr, D, MIX, D, 0, (bf16*)(ws + WS_WOUT));
        else if ((r -= PI_OUT) < 2 * PI_GU) { const int l = r / PI_GU; r -= l * PI_GU;
            m = mk_mat(in[I_WGATE] + (size_t)l * D * FF, in[I_WUP] + (size_t)l * D * FF, nullptr, FF, D, NGU, 2, (bf16*)(ws + WS_WGU + l * al((size_t)NGU * D * 2))); }
        else if ((r -= 2 * PI_GU) < 2 * PI_DN) { const int l = r / PI_DN; r -= l * PI_DN;
            m = mk_mat(in[I_WDOWN] + (size_t)l * FF * D, nullptr, nullptr, D, FF, D, 0, (bf16*)(ws + WS_WDN + l * al((size_t)D * FF * 2))); }
        else { r -= 2 * PI_DN; const int g = r / PI_PL; r -= g * PI_PL;
            m = mk_mat(in[I_WPOOL] + (size_t)g * 65536, nullptr, in[I_POOLSCALE] + g * 256, 256, 256, 256, 3, (bf16*)(ws + WS_WPOOL) + (size_t)g * 65536); }
        prep_item(m, r, scr, lane);
    }
}

__device__ __forceinline__ const float* x_row(const float* xp, const float* xs, int r) { return r < MP ? xp + (size_t)r * D : xs + (size_t)(r - MP) * D; }

__device__ __forceinline__ void norm0_phase(const float* xp, const float* xs, const float* g, bf16* U, int gw, int ngw, int lane) {
    for (int r = gw; r < MPAD; r += ngw) {
        bf16* o = U + (size_t)r * D;
        if (r >= MR) {
#pragma unroll
            for (int j = 0; j < 4; ++j) *(u32x2*)(o + 4 * lane + 256 * j) = (u32x2){0u, 0u};
            continue; }
        const float* x = x_row(xp, xs, r);
        f32x4 v[4]; float ss = 0.f;
#pragma unroll
        for (int j = 0; j < 4; ++j) { v[j] = *(const f32x4*)(x + 4 * lane + 256 * j); ss += v[j].x * v[j].x + v[j].y * v[j].y + v[j].z * v[j].z + v[j].w * v[j].w; }
        const float rstd = 1.0f / sqrtf(wave_sum(ss) * (1.0f / D) + EPS);
#pragma unroll
        for (int j = 0; j < 4; ++j) { const f32x4 gg = *(const f32x4*)(g + 4 * lane + 256 * j); st_bf4(o + 4 * lane + 256 * j, v[j] * rstd * gg); }
    }
}

__device__ __forceinline__ void conv_phase(const bf16* proj, const float* sconv, const float* cw, const float* cb, const float* big, const float* bfg,
                                           const float* dtb, const float* alog, bf16* XC, float* G, float* out, size_t t0, size_t nthr) {
    for (size_t i = t0; i < (size_t)MR * (CONVD / 4); i += nthr) {
        const int r = (int)(i / (CONVD / 4)), c = 4 * (int)(i % (CONVD / 4));
        f32x4 acc = *(const f32x4*)(cb + c);
#pragma unroll
        for (int j = 0; j < 4; ++j) {
            f32x4 xv;
            if (r < MP) { const int t = r & (SEQ - 1); if (t - 3 + j < 0) continue; xv = ld_bf4(proj + (size_t)(r - 3 + j) * NIN + PX + c); }
            else { const int b = r - MP; if (j < 3) xv = *(const f32x4*)(sconv + ((size_t)b * 3 + j) * CONVD + c); else xv = ld_bf4(proj + (size_t)r * NIN + PX + c); }
            acc += xv * *(const f32x4*)(cw + (size_t)j * CONVD + c);
        }
        f32x4 y; y.x = silu_x(acc.x); y.y = silu_x(acc.y); y.z = silu_x(acc.z); y.w = silu_x(acc.w);
        st_bf4(XC + (size_t)r * CONVD + c, y);
    }
    for (size_t i = t0; i < (size_t)BATCH * 3 * (CONVD / 4); i += nthr) {
        const int c = 4 * (int)(i % (CONVD / 4)), j = (int)(i / (CONVD / 4)) % 3, b = (int)(i / (CONVD / 4)) / 3;
        *(f32x4*)(out + O_CVP + ((size_t)b * 3 + j) * CONVD + c) = ld_bf4(proj + (size_t)(b * SEQ + SEQ - 3 + j) * NIN + PX + c);
    }
    for (size_t i = t0; i < (size_t)MS * 3 * (CONVD / 4); i += nthr) {
        const int c = 4 * (int)(i % (CONVD / 4)), j = (int)(i / (CONVD / 4)) % 3, b = (int)(i / (CONVD / 4)) / 3;
        f32x4 v; if (j < 2) v = *(const f32x4*)(sconv + ((size_t)b * 3 + j + 1) * CONVD + c); else v = ld_bf4(proj + (size_t)(MP + b) * NIN + PX + c);
        *(f32x4*)(out + O_CVS + ((size_t)b * 3 + j) * CONVD + c) = v;
    }
    for (size_t i = t0; i < (size_t)MR * 24; i += nthr) {
        const int r = (int)(i / 24), k = (int)(i % 24);
        const float pre = bf2f(proj[(size_t)r * NIN + PG + k]);
        float* g = G + (size_t)r * GW;
        if (k < 4) g[k] = softcap_f(pre + big[k]);
        else if (k < 8) { const float x = softcap_f(pre + bfg[k - 4]); g[k] = fminf(x, 0.f) - log1pf(expf(-fabsf(x))); }
        else { const int hd = k - 8; const float dt = softplus_f(pre + dtb[hd]); g[8 + hd] = dt; g[24 + hd] = -dt * expf(alog[hd]); }
    }
}

constexpr int MLN_LDS_F = 4096 + 4096 + 512 + 4096 + 64 + 80 + 16;
__device__ __forceinline__ void mlstm_prompt_naive(const bf16* proj, const float* G, bf16* HY, float* out, int item, LAS float* L, int tid  ) {
    const int vs = item & 7, h = (item >> 3) & 3, b = item >> 5;
    const int dg = tid >> 5, vv = tid & 31, lane = tid & 63, wave = tid >> 6;
    LAS float* qs = L; LAS float* ks = L + 4096; LAS float* vsh = L + 8192; LAS float* pnum = L + 8704; LAS float* pqn = L + 12800;
    LAS float* mts = L + 12864; LAS float* decs = mts + 16; LAS float* wsh = mts + 32; LAS float* lis = mts + 48; LAS float* lfs = mts + 64; LAS float* mc = mts + 80;
    float c[32];
#pragma unroll
    for (int i = 0; i < 32; ++i) c[i] = 0.f;
    float nd = 0.f;
    if (tid == 0) mc[0] = 0.f;
    for (int t0 = 0; t0 < SEQ; t0 += 16) {
        __syncthreads();
        const size_t row0 = (size_t)b * SEQ + t0;
        for (int tt = 0; tt < 16; ++tt) {
            qs[tt * 256 + tid] = bf2f(proj[(row0 + tt) * NIN + PQ + h * 256 + tid]);
            ks[tt * 256 + tid] = bf2f(proj[(row0 + tt) * NIN + PK + h * 256 + tid]);
        }
        for (int e = tid; e < 16 * 32; e += 256) { const int tt = e >> 5, v = e & 31; vsh[e] = bf2f(proj[(row0 + tt) * NIN + PV + h * 256 + vs * 32 + v]); }
        if (tid < 16) { lis[tid] = G[(row0 + tid) * GW + h]; lfs[tid] = G[(row0 + tid) * GW + 4 + h]; }
        __syncthreads();
        if (tid == 0) {
            float m = mc[0];
            for (int tt = 0; tt < 16; ++tt) { const float li = lis[tt], lf = lfs[tt]; const float mn = fmaxf(lf + m, li); decs[tt] = expf(lf + m - mn); wsh[tt] = expf(li - mn); mts[tt] = mn; m = mn; }
            mc[0] = m;
        }
        __syncthreads();
        for (int tt = 0; tt < 16; ++tt) {
            const float dec = decs[tt], w = wsh[tt];
            const float vval = vsh[tt * 32 + vv] * w;
            float acc = 0.f;
#pragma unroll
            for (int i = 0; i < 32; ++i) { c[i] = dec * c[i] + ks[tt * 256 + dg * 32 + i] * vval; acc += qs[tt * 256 + dg * 32 + i] * c[i]; }
            pnum[(tt * 8 + dg) * 32 + vv] = acc;
            nd = dec * nd + w * ks[tt * 256 + tid];
            const float qn = wave_sum(qs[tt * 256 + tid] * nd);
            if (lane == 0) pqn[tt * 4 + wave] = qn;
        }
        __syncthreads();
#pragma unroll
        for (int rep = 0; rep < 2; ++rep) {
            const int tt = (tid >> 5) + 8 * rep;
            float num = 0.f;
#pragma unroll
            for (int g8 = 0; g8 < 8; ++g8) num += pnum[(tt * 8 + g8) * 32 + vv];
            const float den = (pqn[tt * 4 + 0] + pqn[tt * 4 + 1]) + (pqn[tt * 4 + 2] + pqn[tt * 4 + 3]);
            const float hval = num / fmaxf(fabsf(den), expf(-mts[tt]));
            HY[(row0 + tt) * MIX + h * 256 + vs * 32 + vv] = (bf16)f2bf(hval);
        }
    }
    __syncthreads();
#pragma unroll
    for (int i = 0; i < 32; ++i) out[O_CP + ((size_t)(b * MH + h) * MDK + dg * 32 + i) * MDV + vs * 32 + vv] = c[i];
    if (vs == 0) { out[O_NP + (size_t)(b * MH + h) * MDK + tid] = nd; if (tid == 0) out[O_MP + b * MH + h] = mc[0]; }
}

__device__ __forceinline__ void mlstm_sample_item(const bf16* proj, const float* G, const float* cin, const float* nin, const float* min_, bf16* HY, float* out, int item, LAS float* L, int tid) {
    const int h = item & 3, b = item >> 2, lane = tid & 63, wave = tid >> 6;
    const size_t row = (size_t)MP + b;
    LAS float* qs = L; LAS float* ks = L + 256; LAS float* red = L + 512; LAS float* qnr = L + 1536;
    __syncthreads();
    qs[tid] = bf2f(proj[row * NIN + PQ + h * 256 + tid]); ks[tid] = bf2f(proj[row * NIN + PK + h * 256 + tid]);
    const float li = G[row * GW + h], lf = G[row * GW + 4 + h], m = min_[b * MH + h];
    const float mn = fmaxf(lf + m, li), dec = expf(lf + m - mn), w = expf(li - mn);
    __syncthreads();
    const float nd = dec * nin[(size_t)(b * MH + h) * MDK + tid] + w * ks[tid];
    out[O_NS + (size_t)(b * MH + h) * MDK + tid] = nd;
    const float qn = wave_sum(qs[tid] * nd);
    if (lane == 0) qnr[wave] = qn;
    const int dq = tid >> 6, v4 = tid & 63;
    const f32x4 vv = ld_bf4(proj + row * NIN + PV + h * 256 + 4 * v4) * w;
    f32x4 acc = (f32x4){0.f, 0.f, 0.f, 0.f};
    const float* cbase = cin + ((size_t)(b * MH + h) * MDK) * MDV + 4 * v4;
    float* obase = out + O_CS + ((size_t)(b * MH + h) * MDK) * MDV + 4 * v4;
    for (int d = dq * 64; d < dq * 64 + 64; ++d) {
        const f32x4 c4 = *(const f32x4*)(cbase + (size_t)d * MDV);
        const f32x4 cn = c4 * dec + vv * ks[d];
        *(f32x4*)(obase + (size_t)d * MDV) = cn;
        acc += cn * qs[d];
    }
    red[dq * 256 + 4 * v4 + 0] = acc.x; red[dq * 256 + 4 * v4 + 1] = acc.y; red[dq * 256 + 4 * v4 + 2] = acc.z; red[dq * 256 + 4 * v4 + 3] = acc.w;
    __syncthreads();
    const float num = (red[tid] + red[256 + tid]) + (red[512 + tid] + red[768 + tid]);
    const float den = (qnr[0] + qnr[1]) + (qnr[2] + qnr[3]);
    HY[row * MIX + h * 256 + tid] = (bf16)f2bf(num / fmaxf(fabsf(den), expf(-mn)));
    if (tid == 0) out[O_MS + b * MH + h] = mn;
}

constexpr int SSN_LDS_F = 1024 + 2304 + 2304 + 32;
__device__ __forceinline__ void ssd_prompt_naive(const bf16* XC, const float* G, const float* dskip, bf16* HY, float* out, int item, LAS float* L, int tid) {
    const int head = item & 15, b = item >> 4, g = head >> 3;
    const int p = tid >> 2, nq = tid & 3;
    LAS float* xs = L; LAS float* Bs = L + 1024; LAS float* Cs = L + 3328; LAS float* dts = L + 5632; LAS float* as_ = L + 5648;
    float hst[32];
#pragma unroll
    for (int i = 0; i < 32; ++i) hst[i] = 0.f;
    const float dsk = dskip[head];
    for (int t0 = 0; t0 < SEQ; t0 += 16) {
        __syncthreads();
        const size_t row0 = (size_t)b * SEQ + t0;
        for (int e = tid; e < 16 * 64; e += 256) { const int tt = e >> 6, pp = e & 63; xs[e] = bf2f(XC[(row0 + tt) * CONVD + head * 64 + pp]); }
        for (int e = tid; e < 16 * 128; e += 256) { const int tt = e >> 7, n = e & 127;
            Bs[(tt * 4 + (n >> 5)) * 36 + (n & 31)] = bf2f(XC[(row0 + tt) * CONVD + 1024 + g * 128 + n]);
            Cs[(tt * 4 + (n >> 5)) * 36 + (n & 31)] = bf2f(XC[(row0 + tt) * CONVD + 1280 + g * 128 + n]); }
        if (tid < 16) { dts[tid] = G[(row0 + tid) * GW + 8 + head]; as_[tid] = G[(row0 + tid) * GW + 24 + head]; }
        __syncthreads();
        for (int tt = 0; tt < 16; ++tt) {
            const float decay = expf(as_[tt]), xv = xs[tt * 64 + p], coef = dts[tt] * xv;
            float acc = 0.f;
#pragma unroll
            for (int i = 0; i < 32; ++i) { hst[i] = decay * hst[i] + coef * Bs[(tt * 4 + nq) * 36 + i]; acc += Cs[(tt * 4 + nq) * 36 + i] * hst[i]; }
            acc += __shfl_xor(acc, 1); acc += __shfl_xor(acc, 2);
            if (nq == 0) HY[(row0 + tt) * MIX + 1024 + head * 64 + p] = (bf16)f2bf(acc + dsk * xv);
        }
    }
#pragma unroll
    for (int i = 0; i < 32; ++i) out[O_SSP + ((size_t)(b * SH + head) * SP + p) * SN + nq * 32 + i] = hst[i];
}

__device__ __forceinline__ void ssd_sample_item(const bf16* XC, const float* G, const float* dskip, const float* sin_, bf16* HY, float* out, int item, int tid) {
    const int head = item & 15, b = item >> 4, g = head >> 3;
    const int pj = tid >> 5, n4 = tid & 31;
    const size_t row = (size_t)MP + b;
    const float dt = G[row * GW + 8 + head], decay = expf(G[row * GW + 24 + head]), dsk = dskip[head];
    const f32x4 B4 = ld_bf4(XC + row * CONVD + 1024 + g * 128 + 4 * n4), C4 = ld_bf4(XC + row * CONVD + 1280 + g * 128 + 4 * n4);
#pragma unroll
    for (int j = 0; j < 8; ++j) {
        const int p = pj + 8 * j;
        const float xv = bf2f(XC[row * CONVD + head * 64 + p]);
        const size_t off = ((size_t)(b * SH + head) * SP + p) * SN + 4 * n4;
        const f32x4 hn = *(const f32x4*)(sin_ + off) * decay + B4 * (dt * xv);
        *(f32x4*)(out + O_SSS + off) = hn;
        float acc = C4.x * hn.x + C4.y * hn.y + C4.z * hn.z + C4.w * hn.w;
#pragma unroll
        for (int o = 1; o < 32; o <<= 1) acc += __shfl_xor(acc, o);
        if (n4 == 0) HY[row * MIX + 1024 + head * 64 + p] = (bf16)f2bf(acc + dsk * xv);
    }
}

__device__ __forceinline__ void finish_phase(const bf16* proj, const float* gml, const float* gssm, bf16* HY, int gw, int ngw, int lane) {
    for (int r = gw; r < MPAD; r += ngw) {
        bf16* hy = HY + (size_t)r * MIX;
        if (r >= MR) {
#pragma unroll
            for (int j = 0; j < 8; ++j) *(u32x2*)(hy + 4 * lane + 256 * j) = (u32x2){0u, 0u};
            continue; }
        const bf16* pr = proj + (size_t)r * NIN;
        f32x4 v[8]; float ss[8];
#pragma unroll
        for (int j = 0; j < 8; ++j) {
            v[j] = ld_bf4(hy + 4 * lane + 256 * j);
            if (j >= 4) { const f32x4 z = ld_bf4(pr + PZ + 4 * lane + 256 * (j - 4)); v[j].x *= silu_x(z.x); v[j].y *= silu_x(z.y); v[j].z *= silu_x(z.z); v[j].w *= silu_x(z.w); }
            ss[j] = wave_sum(v[j].x * v[j].x + v[j].y * v[j].y + v[j].z * v[j].z + v[j].w * v[j].w);
        }
#pragma unroll
        for (int j = 0; j < 8; ++j) {
            const int col = 4 * lane + 256 * j;
            f32x4 o;
            if (j < 4) {
                const float rstd = 1.0f / sqrtf(ss[j] * (1.0f / 256.0f) + EPS);
                const f32x4 gg = *(const f32x4*)(gml + col), og = ld_bf4(pr + PO + col);
                o = v[j] * rstd * gg; o.x *= sigmoid_f(og.x); o.y *= sigmoid_f(og.y); o.z *= sigmoid_f(og.z); o.w *= sigmoid_f(og.w);
            } else {
                const int j0 = 4 + ((j - 4) & ~1);
                const float rstd = 1.0f / sqrtf((ss[j0] + ss[j0 + 1]) * (1.0f / 512.0f) + EPS);
                o = v[j] * rstd * *(const f32x4*)(gssm + col - 1024);
            }
            st_bf4(hy + col, o);
        }
    }
}

__device__ __forceinline__ void rowpass_phase(const float* xp, const float* xs, const float* xin, const float* outf, const float* gpost, const float* gnext,
                                              float* xout, bf16* UB, float* UF, int gw, int ngw, int lane) {
    for (int r = gw; r < MPAD; r += ngw) {
        if (r >= MR) {
            if (UB) {
#pragma unroll
                for (int j = 0; j < 4; ++j) *(u32x2*)(UB + (size_t)r * D + 4 * lane + 256 * j) = (u32x2){0u, 0u}; }
            continue; }
        const float* xi = xin ? xin + (size_t)r * D : x_row(xp, xs, r);
        f32x4 o[4], x[4]; float ss = 0.f;
#pragma unroll
        for (int j = 0; j < 4; ++j) { o[j] = *(const f32x4*)(outf + (size_t)r * D + 4 * lane + 256 * j); x[j] = *(const f32x4*)(xi + 4 * lane + 256 * j);
            ss += o[j].x * o[j].x + o[j].y * o[j].y + o[j].z * o[j].z + o[j].w * o[j].w; }
        const float rstd = 1.0f / sqrtf(wave_sum(ss) * (1.0f / D) + EPS);
        float ss2 = 0.f;
#pragma unroll
        for (int j = 0; j < 4; ++j) { x[j] += o[j] * rstd * *(const f32x4*)(gpost + 4 * lane + 256 * j); *(f32x4*)(xout + (size_t)r * D + 4 * lane + 256 * j) = x[j];
            ss2 += x[j].x * x[j].x + x[j].y * x[j].y + x[j].z * x[j].z + x[j].w * x[j].w; }
        if (gnext) {
            const float rstd2 = 1.0f / sqrtf(wave_sum(ss2) * (1.0f / D) + EPS);
#pragma unroll
            for (int j = 0; j < 4; ++j) { const f32x4 u = x[j] * rstd2 * *(const f32x4*)(gnext + 4 * lane + 256 * j);
                if (UB) st_bf4(UB + (size_t)r * D + 4 * lane + 256 * j, u);
                if (UF) *(f32x4*)(UF + (size_t)r * D + 4 * lane + 256 * j) = u; }
        }
    }
}

__device__ __forceinline__ void pool_phase(const float* U2F, const float* spool, bf16* DP, float* out, size_t t0, size_t nthr) {
    for (size_t i = t0; i < (size_t)MPAD * (D / 4); i += nthr) {
        const int r = (int)(i / (D / 4)), c = 4 * (int)(i % (D / 4));
        if (r >= MR) { *(u32x2*)(DP + (size_t)r * D + c) = (u32x2){0u, 0u}; continue; }
        const int w = 2 << (c >> 8);
        const f32x4 u = *(const f32x4*)(U2F + (size_t)r * D + c);
        f32x4 s = u; float cnt;
        if (r < MP) { const int t = r & (SEQ - 1); const int n = (t + 1 < w) ? t + 1 : w; cnt = (float)n;
            for (int k = 1; k < n; ++k) s += *(const f32x4*)(U2F + (size_t)(r - k) * D + c); }
        else { const int b = r - MP; cnt = (float)w;
            for (int k = 1; k < w; ++k) s += *(const f32x4*)(spool + ((size_t)b * 15 + 15 - k) * D + c); }
        st_bf4(DP + (size_t)r * D + c, s / cnt - u);
    }
    for (size_t i = t0; i < (size_t)BATCH * 15 * (D / 4); i += nthr) {
        const int c = 4 * (int)(i % (D / 4)), j = (int)(i / (D / 4)) % 15, b = (int)(i / (D / 4)) / 15;
        *(f32x4*)(out + O_PLP + ((size_t)b * 15 + j) * D + c) = *(const f32x4*)(U2F + (size_t)(b * SEQ + SEQ - 15 + j) * D + c);
    }
    for (size_t i = t0; i < (size_t)MS * 15 * (D / 4); i += nthr) {
        const int c = 4 * (int)(i % (D / 4)), j = (int)(i / (D / 4)) % 15, b = (int)(i / (D / 4)) / 15;
        f32x4 v; if (j < 14) v = *(const f32x4*)(spool + ((size_t)b * 15 + j + 1) * D + c); else v = *(const f32x4*)(U2F + (size_t)(MP + b) * D + c);
        *(f32x4*)(out + O_PLS + ((size_t)b * 15 + j) * D + c) = v;
    }
}
typedef short bf16x8 __attribute__((ext_vector_type(8)));
typedef short s16x4 __attribute__((ext_vector_type(4)));
typedef short v4i16_t __attribute__((ext_vector_type(4)));
__device__ __forceinline__ bf16x8 rowfrag(const LAS unsigned char* img, int ld, int row0, int k0, int fr, int fq) {
    return *(const LAS bf16x8*)(img + (row0 + fr) * ld + (k0 + 8 * fq) * 2);
}
__device__ __forceinline__ s16x4 vtr(const LAS unsigned char* p) { return __builtin_bit_cast(s16x4, __builtin_amdgcn_ds_read_tr16_b64_v4i16((LAS v4i16_t*)p)); }
__device__ __forceinline__ bf16x8 trfrag(const LAS unsigned char* img, int ld, int k0, int m0, int fr, int fq) {
    const LAS unsigned char* a = img + (k0 + 8 * fq + (fr >> 2)) * ld + (m0 + 4 * (fr & 3)) * 2;
    const s16x4 lo = vtr(a), hi = vtr(a + 4 * ld);
    return (bf16x8){lo[0], lo[1], lo[2], lo[3], hi[0], hi[1], hi[2], hi[3]};
}
__device__ __forceinline__ bf16x8 scale8(bf16x8 x, f32x4 w0, f32x4 w1) {
    u32x4 r;
    r.x = pg8::cvt_pk_bf16(bf2f((unsigned short)x[0]) * w0.x, bf2f((unsigned short)x[1]) * w0.y);
    r.y = pg8::cvt_pk_bf16(bf2f((unsigned short)x[2]) * w0.z, bf2f((unsigned short)x[3]) * w0.w);
    r.z = pg8::cvt_pk_bf16(bf2f((unsigned short)x[4]) * w1.x, bf2f((unsigned short)x[5]) * w1.y);
    r.w = pg8::cvt_pk_bf16(bf2f((unsigned short)x[6]) * w1.z, bf2f((unsigned short)x[7]) * w1.w);
    return __builtin_bit_cast(bf16x8, r);
}
#define MFMA16(a, b, c) __builtin_amdgcn_mfma_f32_16x16x32_bf16((a), (b), (c), 0, 0, 0)

namespace ms {
constexpr int LDQ = 528, LDV = 144;
constexpr int Q = 0, K = Q + 64 * LDQ, VT = K + 64 * LDQ, P = VT + 80 * LDV, CT = P + 64 * LDV, GA = CT + 80 * LDQ;
constexpr int END = GA + (5 * 64 + 16) * 4;
}
__device__ __forceinline__ void mlstm_scan_mfma(const bf16* proj, const float* G, bf16* HY, float* out, int job, LAS unsigned char* L, int tid) {
    const int vq = job & 3, h = (job >> 2) & 3, b = job >> 4;
    const int lane = tid & 63, w = __builtin_amdgcn_readfirstlane(tid >> 6), fr = lane & 15, fq = lane >> 4;
    LAS float* A_ = (LAS float*)(L + ms::GA); LAS float* MX = A_ + 64; LAS float* IW = A_ + 128; LAS float* W_ = A_ + 192; LAS float* EMT = A_ + 256; LAS float* SC = A_ + 320;
    __syncthreads();
    for (int i = tid; i < 80 * ms::LDQ / 16; i += NTHREADS) *(LAS u32x4*)(L + ms::CT + 16 * i) = (u32x4){0u, 0u, 0u, 0u};
    for (int i = tid; i < 16 * ms::LDV / 4; i += NTHREADS) ((LAS unsigned*)(L + ms::VT + 64 * ms::LDV))[i] = (i < 32) ? 0x3F803F80u : 0u;
    f32x4 acc[2][5];
#pragma unroll
    for (int a = 0; a < 2; ++a)
#pragma unroll
        for (int v = 0; v < 5; ++v) acc[a][v] = (f32x4){0.f, 0.f, 0.f, 0.f};
    float m_run = 0.f;
    u32x4 rq[4], rk[4], rv; float rli = 0.f, rlf = 0.f;
    const int prow = tid >> 5, pc16 = tid & 31, vrow = tid >> 3, vc = tid & 7;
#define ML_LOAD(j) do { const size_t r0_ = (size_t)b * SEQ + 64 * (j); \
        _Pragma("unroll") for (int i = 0; i < 4; ++i) { const bf16* p_ = proj + (r0_ + prow + 16 * i) * NIN + h * 256 + pc16 * 8; rq[i] = *(const u32x4*)(p_ + PQ); rk[i] = *(const u32x4*)(p_ + PK); } \
        rv = *(const u32x4*)(proj + (r0_ + vrow) * NIN + PV + h * 256 + vq * 64 + vc * 8); \
        if (w == 0) { rli = G[(r0_ + lane) * GW + h]; rlf = G[(r0_ + lane) * GW + 4 + h]; } } while (0)
#define ML_STORE() do { \
        _Pragma("unroll") for (int i = 0; i < 4; ++i) { *(LAS u32x4*)(L + ms::Q + (prow + 16 * i) * ms::LDQ + pc16 * 16) = rq[i]; *(LAS u32x4*)(L + ms::K + (prow + 16 * i) * ms::LDQ + pc16 * 16) = rk[i]; } \
        { LAS unsigned short* vt_ = (LAS unsigned short*)(L + ms::VT + (8 * vc) * ms::LDV + vrow * 2); \
          vt_[0 * (ms::LDV / 2)] = (unsigned short)(rv.x & 0xffffu); vt_[1 * (ms::LDV / 2)] = (unsigned short)(rv.x >> 16); vt_[2 * (ms::LDV / 2)] = (unsigned short)(rv.y & 0xffffu); vt_[3 * (ms::LDV / 2)] = (unsigned short)(rv.y >> 16); \
          vt_[4 * (ms::LDV / 2)] = (unsigned short)(rv.z & 0xffffu); vt_[5 * (ms::LDV / 2)] = (unsigned short)(rv.z >> 16); vt_[6 * (ms::LDV / 2)] = (unsigned short)(rv.w & 0xffffu); vt_[7 * (ms::LDV / 2)] = (unsigned short)(rv.w >> 16); } \
        if (w == 0) { float bb = rlf; \
            _Pragma("unroll") for (int o = 1; o < 64; o <<= 1) { const float v_ = __shfl_up(bb, o); if (lane >= o) bb += v_; } \
            const float a_ = rli - bb; float pm = a_; \
            _Pragma("unroll") for (int o = 1; o < 64; o <<= 1) { const float v_ = __shfl_up(pm, o); if (lane >= o) pm = fmaxf(pm, v_); } \
            const float mx = fmaxf(m_run, pm), iw = __expf(m_run - mx); \
            const float mx63 = __shfl(mx, 63), b63 = __shfl(bb, 63); \
            A_[lane] = a_; MX[lane] = mx; IW[lane] = iw; W_[lane] = __expf(a_ - mx63); EMT[lane] = __expf(-(bb + mx)); \
            if (lane == 63) SC[0] = iw; \
            m_run = b63 + mx63; } } while (0)
    ML_LOAD(0);
    ML_STORE();
    __syncthreads();
    for (int j = 0; j < SEQ / 64; ++j) {
        const size_t row0 = (size_t)b * SEQ + 64 * j;
        if (j + 1 < SEQ / 64) ML_LOAD(j + 1);
        {
            const int tt = w >> 1;
            const float mxt = MX[16 * tt + fr];
#pragma unroll
            for (int sti = 0; sti < 2; ++sti) {
                const int st = 2 * (w & 1) + sti;
                u32x2 pk = (u32x2){0u, 0u};
                if (st <= tt) {
                    f32x4 s = (f32x4){0.f, 0.f, 0.f, 0.f};
#pragma unroll
                    for (int ks = 0; ks < 8; ++ks) s = MFMA16(rowfrag(L + ms::K, ms::LDQ, 16 * st, 32 * ks, fr, fq), rowfrag(L + ms::Q, ms::LDQ, 16 * tt, 32 * ks, fr, fq), s);
                    const f32x4 a4 = *(const LAS f32x4*)(A_ + 16 * st + 4 * fq);
                    const int t = 16 * tt + fr, s0 = 16 * st + 4 * fq;
                    const float p0 = (s0 + 0 <= t) ? s[0] * __expf(a4[0] - mxt) : 0.f;
                    const float p1 = (s0 + 1 <= t) ? s[1] * __expf(a4[1] - mxt) : 0.f;
                    const float p2 = (s0 + 2 <= t) ? s[2] * __expf(a4[2] - mxt) : 0.f;
                    const float p3 = (s0 + 3 <= t) ? s[3] * __expf(a4[3] - mxt) : 0.f;
                    pk.x = pg8::cvt_pk_bf16(p0, p1); pk.y = pg8::cvt_pk_bf16(p2, p3);
                }
                *(LAS u32x2*)(L + ms::P + (16 * tt + fr) * ms::LDV + (16 * st + 4 * fq) * 2) = pk;
            }
            const float dec = SC[0];
#pragma unroll
            for (int a = 0; a < 2; ++a)
#pragma unroll
                for (int v = 0; v < 5; ++v) acc[a][v] *= dec;
#pragma unroll
            for (int ks = 0; ks < 2; ++ks) {
                const f32x4 w0 = *(const LAS f32x4*)(W_ + 32 * ks + 8 * fq), w1 = *(const LAS f32x4*)(W_ + 32 * ks + 8 * fq + 4);
                bf16x8 bfr[5];
#pragma unroll
                for (int v = 0; v < 5; ++v) bfr[v] = rowfrag(L + ms::VT, ms::LDV, 16 * v, 32 * ks, fr, fq);
#pragma unroll
                for (int a = 0; a < 2; ++a) {
                    const bf16x8 kf = scale8(trfrag(L + ms::K, ms::LDQ, 32 * ks, 16 * (2 * w + a), fr, fq), w0, w1);
#pragma unroll
                    for (int v = 0; v < 5; ++v) acc[a][v] = MFMA16(kf, bfr[v], acc[a][v]);
                }
            }
        }
        __syncthreads();
        {
            const int tt = w & 3, t = 16 * tt + fr, vb = (w < 4) ? 0 : 2;
            f32x4 n2[3], n1[3];
#pragma unroll
            for (int i = 0; i < 3; ++i) { n2[i] = (f32x4){0.f, 0.f, 0.f, 0.f}; n1[i] = (f32x4){0.f, 0.f, 0.f, 0.f}; }
#pragma unroll
            for (int ks = 0; ks < 8; ++ks) {
                const bf16x8 bq = rowfrag(L + ms::Q, ms::LDQ, 16 * tt, 32 * ks, fr, fq);
#pragma unroll
                for (int i = 0; i < 3; ++i) n2[i] = MFMA16(rowfrag(L + ms::CT, ms::LDQ, 16 * (i < 2 ? vb + i : 4), 32 * ks, fr, fq), bq, n2[i]);
            }
#pragma unroll
            for (int ks = 0; ks < 2; ++ks) {
                if (32 * ks <= 16 * tt + 15) {
                    const bf16x8 bp = rowfrag(L + ms::P, ms::LDV, 16 * tt, 32 * ks, fr, fq);
#pragma unroll
                    for (int i = 0; i < 3; ++i) n1[i] = MFMA16(rowfrag(L + ms::VT, ms::LDV, 16 * (i < 2 ? vb + i : 4), 32 * ks, fr, fq), bp, n1[i]);
                }
            }
            const float iwt = IW[t];
            const float den = __shfl(n1[2][0] + iwt * n2[2][0], fr);
            const float sc = 1.0f / fmaxf(fabsf(den), EMT[t]);
#pragma unroll
            for (int i = 0; i < 2; ++i) {
                const f32x4 hv = (n1[i] + n2[i] * iwt) * sc;
                u32x2 pk; pk.x = pg8::cvt_pk_bf16(hv[0], hv[1]); pk.y = pg8::cvt_pk_bf16(hv[2], hv[3]);
                *(u32x2*)(HY + (row0 + t) * MIX + h * 256 + vq * 64 + 16 * (vb + i) + 4 * fq) = pk;
            }
        }
        __syncthreads();
#pragma unroll
        for (int a = 0; a < 2; ++a)
#pragma unroll
            for (int v = 0; v < 5; ++v) { u32x2 pk; pk.x = pg8::cvt_pk_bf16(acc[a][v][0], acc[a][v][1]); pk.y = pg8::cvt_pk_bf16(acc[a][v][2], acc[a][v][3]);
                *(LAS u32x2*)(L + ms::CT + (16 * v + fr) * ms::LDQ + (32 * w + 16 * a + 4 * fq) * 2) = pk; }
        if (j + 1 < SEQ / 64) ML_STORE();
        __syncthreads();
    }
#undef ML_LOAD
#undef ML_STORE
#pragma unroll
    for (int a = 0; a < 2; ++a)
#pragma unroll
        for (int v = 0; v < 4; ++v)
#pragma unroll
            for (int jj = 0; jj < 4; ++jj) out[O_CP + ((size_t)(b * MH + h) * MDK + 32 * w + 16 * a + 4 * fq + jj) * MDV + vq * 64 + 16 * v + fr] = acc[a][v][jj];
    if (vq == 0) {
        if (fr == 0) {
#pragma unroll
            for (int a = 0; a < 2; ++a)
#pragma unroll
                for (int jj = 0; jj < 4; ++jj) out[O_NP + (size_t)(b * MH + h) * MDK + 32 * w + 16 * a + 4 * fq + jj] = acc[a][4][jj];
        }
        if (tid == 0) out[O_MP + b * MH + h] = m_run;
    }
}

namespace ss {
constexpr int LDN = 272, LDS_ = 144;
constexpr int BS = 0, CS = BS + 64 * LDN, XT = CS + 64 * LDN, PS = XT + 64 * LDS_, HB = PS + 64 * LDS_, GA = HB + 64 * LDN;
constexpr int END = GA + (4 * 64 + 16) * 4;
}
__device__ __forceinline__ void ssd_scan_mfma(const bf16* XC, const float* G, const float* dskip, bf16* HY, float* out, int job, LAS unsigned char* L, int tid) {
    const int head = job & 15, b = job >> 4, g = head >> 3;
    const int lane = tid & 63, w = __builtin_amdgcn_readfirstlane(tid >> 6), fr = lane & 15, fq = lane >> 4;
    LAS float* CUM = (LAS float*)(L + ss::GA); LAS float* DT = CUM + 64; LAS float* ECUM = CUM + 128; LAS float* WEND = CUM + 192; LAS float* SC = CUM + 256;
    __syncthreads();
    for (int i = tid; i < 64 * ss::LDN / 16; i += NTHREADS) *(LAS u32x4*)(L + ss::HB + 16 * i) = (u32x4){0u, 0u, 0u, 0u};
    f32x4 acc[4];
#pragma unroll
    for (int p = 0; p < 4; ++p) acc[p] = (f32x4){0.f, 0.f, 0.f, 0.f};
    const float dsk = dskip[head];
    u32x4 rb[2], rc[2], rx; float rdt = 0.f, ra = 0.f;
    const int prow = tid >> 4, pc16 = tid & 15, xrow = tid >> 3, xc = tid & 7;
#define SS_LOAD(j) do { const size_t r0_ = (size_t)b * SEQ + 64 * (j); \
        _Pragma("unroll") for (int i = 0; i < 2; ++i) { const bf16* p_ = XC + (r0_ + prow + 32 * i) * CONVD + g * 128 + pc16 * 8; rb[i] = *(const u32x4*)(p_ + 1024); rc[i] = *(const u32x4*)(p_ + 1280); } \
        rx = *(const u32x4*)(XC + (r0_ + xrow) * CONVD + head * 64 + xc * 8); \
        if (w == 0) { rdt = G[(r0_ + lane) * GW + 8 + head]; ra = G[(r0_ + lane) * GW + 24 + head]; } } while (0)
#define SS_STORE() do { \
        _Pragma("unroll") for (int i = 0; i < 2; ++i) { *(LAS u32x4*)(L + ss::BS + (prow + 32 * i) * ss::LDN + pc16 * 16) = rb[i]; *(LAS u32x4*)(L + ss::CS + (prow + 32 * i) * ss::LDN + pc16 * 16) = rc[i]; } \
        { LAS unsigned short* xt_ = (LAS unsigned short*)(L + ss::XT + (8 * xc) * ss::LDS_ + xrow * 2); \
          xt_[0 * (ss::LDS_ / 2)] = (unsigned short)(rx.x & 0xffffu); xt_[1 * (ss::LDS_ / 2)] = (unsigned short)(rx.x >> 16); xt_[2 * (ss::LDS_ / 2)] = (unsigned short)(rx.y & 0xffffu); xt_[3 * (ss::LDS_ / 2)] = (unsigned short)(rx.y >> 16); \
          xt_[4 * (ss::LDS_ / 2)] = (unsigned short)(rx.z & 0xffffu); xt_[5 * (ss::LDS_ / 2)] = (unsigned short)(rx.z >> 16); xt_[6 * (ss::LDS_ / 2)] = (unsigned short)(rx.w & 0xffffu); xt_[7 * (ss::LDS_ / 2)] = (unsigned short)(rx.w >> 16); } \
        if (w == 0) { float cs = ra; \
            _Pragma("unroll") for (int o = 1; o < 64; o <<= 1) { const float v_ = __shfl_up(cs, o); if (lane >= o) cs += v_; } \
            const float c63 = __shfl(cs, 63); \
            CUM[lane] = cs; DT[lane] = rdt; ECUM[lane] = __expf(cs); WEND[lane] = __expf(c63 - cs) * rdt; \
            if (lane == 63) SC[0] = __expf(cs); } } while (0)
    SS_LOAD(0);
    SS_STORE();
    __syncthreads();
    for (int j = 0; j < SEQ / 64; ++j) {
        const size_t row0 = (size_t)b * SEQ + 64 * j;
        if (j + 1 < SEQ / 64) SS_LOAD(j + 1);
        {
            const int tt = w >> 1;
            const float cumt = CUM[16 * tt + fr];
#pragma unroll
            for (int sti = 0; sti < 2; ++sti) {
                const int st = 2 * (w & 1) + sti;
                u32x2 pk = (u32x2){0u, 0u};
                if (st <= tt) {
                    f32x4 s = (f32x4){0.f, 0.f, 0.f, 0.f};
#pragma unroll
                    for (int ks = 0; ks < 4; ++ks) s = MFMA16(rowfrag(L + ss::BS, ss::LDN, 16 * st, 32 * ks, fr, fq), rowfrag(L + ss::CS, ss::LDN, 16 * tt, 32 * ks, fr, fq), s);
                    const f32x4 c4 = *(const LAS f32x4*)(CUM + 16 * st + 4 * fq), d4 = *(const LAS f32x4*)(DT + 16 * st + 4 * fq);
                    const int t = 16 * tt + fr, s0 = 16 * st + 4 * fq;
                    const float p0 = (s0 + 0 <= t) ? s[0] * __expf(cumt - c4[0]) * d4[0] : 0.f;
                    const float p1 = (s0 + 1 <= t) ? s[1] * __expf(cumt - c4[1]) * d4[1] : 0.f;
                    const float p2 = (s0 + 2 <= t) ? s[2] * __expf(cumt - c4[2]) * d4[2] : 0.f;
                    const float p3 = (s0 + 3 <= t) ? s[3] * __expf(cumt - c4[3]) * d4[3] : 0.f;
                    pk.x = pg8::cvt_pk_bf16(p0, p1); pk.y = pg8::cvt_pk_bf16(p2, p3);
                }
                *(LAS u32x2*)(L + ss::PS + (16 * tt + fr) * ss::LDS_ + (16 * st + 4 * fq) * 2) = pk;
            }
            const float dec = SC[0];
#pragma unroll
            for (int p = 0; p < 4; ++p) acc[p] *= dec;
#pragma unroll
            for (int ks = 0; ks < 2; ++ks) {
                const f32x4 w0 = *(const LAS f32x4*)(WEND + 32 * ks + 8 * fq), w1 = *(const LAS f32x4*)(WEND + 32 * ks + 8 * fq + 4);
                const bf16x8 bf = scale8(trfrag(L + ss::BS, ss::LDN, 32 * ks, 16 * w, fr, fq), w0, w1);
#pragma unroll
                for (int p = 0; p < 4; ++p) acc[p] = MFMA16(bf, rowfrag(L + ss::XT, ss::LDS_, 16 * p, 32 * ks, fr, fq), acc[p]);
            }
        }
        __syncthreads();
        {
            const int tt = w & 3, t = 16 * tt + fr, pb = 2 * (w >> 2);
            f32x4 n2[2], n1[2];
#pragma unroll
            for (int i = 0; i < 2; ++i) { n2[i] = (f32x4){0.f, 0.f, 0.f, 0.f}; n1[i] = (f32x4){0.f, 0.f, 0.f, 0.f}; }
#pragma unroll
            for (int ks = 0; ks < 4; ++ks) {
                const bf16x8 bc = rowfrag(L + ss::CS, ss::LDN, 16 * tt, 32 * ks, fr, fq);
#pragma unroll
                for (int i = 0; i < 2; ++i) n2[i] = MFMA16(rowfrag(L + ss::HB, ss::LDN, 16 * (pb + i), 32 * ks, fr, fq), bc, n2[i]);
            }
#pragma unroll
            for (int ks = 0; ks < 2; ++ks) {
                if (32 * ks <= 16 * tt + 15) {
                    const bf16x8 bp = rowfrag(L + ss::PS, ss::LDS_, 16 * tt, 32 * ks, fr, fq);
#pragma unroll
                    for (int i = 0; i < 2; ++i) n1[i] = MFMA16(rowfrag(L + ss::XT, ss::LDS_, 16 * (pb + i), 32 * ks, fr, fq), bp, n1[i]);
                }
            }
            const float ec = ECUM[t];
#pragma unroll
            for (int i = 0; i < 2; ++i) {
                const int p0 = 16 * (pb + i) + 4 * fq;
                f32x4 y = n1[i] + n2[i] * ec;
#pragma unroll
                for (int jj = 0; jj < 4; ++jj) y[jj] += dsk * bf2f(*(const LAS unsigned short*)(L + ss::XT + (p0 + jj) * ss::LDS_ + t * 2));
                u32x2 pk; pk.x = pg8::cvt_pk_bf16(y[0], y[1]); pk.y = pg8::cvt_pk_bf16(y[2], y[3]);
                *(u32x2*)(HY + (row0 + t) * MIX + 1024 + head * 64 + p0) = pk;
            }
        }
        __syncthreads();
#pragma unroll
        for (int p = 0; p < 4; ++p) { u32x2 pk; pk.x = pg8::cvt_pk_bf16(acc[p][0], acc[p][1]); pk.y = pg8::cvt_pk_bf16(acc[p][2], acc[p][3]);
            *(LAS u32x2*)(L + ss::HB + (16 * p + fr) * ss::LDN + (16 * w + 4 * fq) * 2) = pk; }
        if (j + 1 < SEQ / 64) SS_STORE();
        __syncthreads();
    }
#undef SS_LOAD
#undef SS_STORE
#pragma unroll
    for (int p = 0; p < 4; ++p)
#pragma unroll
        for (int jj = 0; jj < 4; ++jj) out[O_SSP + ((size_t)(b * SH + head) * SP + 16 * p + fr) * SN + 16 * w + 4 * fq + jj] = acc[p][jj];
}
struct Args { const float* in[N_IN]; float* out; unsigned char* ws; };
__global__ void __launch_bounds__(NTHREADS, 2) mega_fwd(Args args) {
    extern __shared__ __attribute__((aligned(16))) unsigned char lds_raw[];
    LAS unsigned char* lds = (LAS unsigned char*)lds_raw;
    const int tid = threadIdx.x, lane = tid & 63, wave = __builtin_amdgcn_readfirstlane(tid >> 6);
    const int G = gridDim.x, bx = blockIdx.x;
    const int vcu = (G % 8 == 0) ? (bx % 8) * (G / 8) + bx / 8 : bx;
    const int gw = vcu * NWAVES + wave, ngw = G * NWAVES;
    const size_t gt = (size_t)vcu * NTHREADS + tid, ngt = (size_t)G * NTHREADS;
    unsigned char* ws = args.ws; float* out = args.out;
    const float* const* in = args.in;
    gu32* ctl = (gu32*)(ws + WS_CTL);
    for (int u = tid; u < (LDS_BYTES - LDSCTL_OFF) / 4; u += NTHREADS) ((LAS unsigned*)(lds + LDSCTL_OFF))[u] = 0u;
    __syncthreads();
    volatile LAS unsigned* MISC = (volatile LAS unsigned*)(lds + MISC_OFF);
    XcdBarrier bar = xcd_barrier_post((unsigned*)(ctl + CW_BAR), MISC + 8);
    bf16* WIN = (bf16*)(ws + WS_WIN); bf16* WOUT = (bf16*)(ws + WS_WOUT); bf16* WPOOL = (bf16*)(ws + WS_WPOOL);
    bf16* U = (bf16*)(ws + WS_U); float* Gt = (float*)(ws + WS_G); bf16* XC = (bf16*)(ws + WS_XC); bf16* HY = (bf16*)(ws + WS_HY);
    bf16* PROJ = (bf16*)(ws + WS_PROJ); float* OUTF = (float*)(ws + WS_OUTF); bf16* HMID = (bf16*)(ws + WS_HMID); float* U2F = (float*)(ws + WS_U2F);
    float* Y = out + O_Y;
#define GEMM_PHASE(EPI, gA, gB, gN, gK, glda, gldb, gpn, epi) do { pg8::Gemm g_{gA, gB, MPAD, gN, gK, glda, gldb, gpn}; pg8::StaticOrder S_; S_.init(MPAD, gN, G, bx); \
        pg8::gemm_phase<EPI, pg8::StaticOrder, true, true>(lds + RING_OFF, g_, S_, epi); } while (0)

    prep_phase(in, ws, (LAS float*)(lds + RING_OFF + wave * 16384), gw, ngw, lane);
    norm0_phase(in[I_XP], in[I_XS], in[I_GMIXPRE], U, gw, ngw, lane);
    xcd_barrier(bar);
    GEMM_PHASE(pg8::EpiBf16, U, WIN, NIN, D, D, D, 0, (pg8::EpiBf16{PROJ, NIN, 0}));
    xcd_barrier(bar);
    conv_phase(PROJ, in[I_SCONV], in[I_CONVW], in[I_CONVB], in[I_BIG], in[I_BFG], in[I_DTBIAS], in[I_ALOG], XC, Gt, out, gt, ngt);
    xcd_barrier(bar);
    {
        static_assert(ms::END <= RING_BYTES && ss::END <= RING_BYTES, "scan LDS maps");
        if (vcu < 128) mlstm_scan_mfma(PROJ, Gt, HY, out, vcu, lds + RING_OFF, tid);
        else ssd_scan_mfma(XC, Gt, in[I_DSKIP], HY, out, vcu - 128, lds + RING_OFF, tid);
        __syncthreads();
        const int half = tid >> 8, ht = tid & 255;
        const int hb = vcu * 2 + half, nhb = G * 2;
        for (int it = hb; it < MS * MH; it += nhb) mlstm_sample_item(PROJ, Gt, in[I_SC], in[I_SN], in[I_SM], HY, out, it, (LAS float*)(lds + RING_OFF) + half * 2048, ht);
        for (int it = hb; it < MS * SH; it += nhb) ssd_sample_item(XC, Gt, in[I_DSKIP], in[I_SSSM], HY, out, it, ht);
    }
    xcd_barrier(bar);
    finish_phase(PROJ, in[I_GMLSTM], in[I_GSSM], HY, gw, ngw, lane);
    xcd_barrier(bar);
    GEMM_PHASE(pg8::EpiF32, HY, WOUT, D, MIX, MIX, MIX, 0, (pg8::EpiF32{OUTF, D, 0}));
    xcd_barrier(bar);
    rowpass_phase(in[I_XP], in[I_XS], nullptr, OUTF, in[I_GMIXPOST], in[I_GFFNPRE], Y, U, nullptr, gw, ngw, lane);
    xcd_barrier(bar);
    GEMM_PHASE(pg8::EpiSwiGLU, U, (bf16*)(ws + WS_WGU), NGU, D, D, D, 0, (pg8::EpiSwiGLU{HMID, FF, 0}));
    xcd_barrier(bar);
    GEMM_PHASE(pg8::EpiF32, HMID, (bf16*)(ws + WS_WDN), D, FF, FF, FF, 0, (pg8::EpiF32{OUTF, D, 0}));
    xcd_barrier(bar);
    rowpass_phase(in[I_XP], in[I_XS], Y, OUTF, in[I_GFFNPOST], in[I_GMIXPRE] + D, Y, nullptr, U2F, gw, ngw, lane);
    xcd_barrier(bar);
    pool_phase(U2F, in[I_SPOOL], U, out, gt, ngt);
    xcd_barrier(bar);
    GEMM_PHASE(pg8::EpiF32, U, WPOOL, D, 256, D, 256, 256, (pg8::EpiF32{OUTF, D, 0}));
    xcd_barrier(bar);
    rowpass_phase(in[I_XP], in[I_XS], Y, OUTF, in[I_GMIXPOST] + D, in[I_GFFNPRE] + D, Y, U, nullptr, gw, ngw, lane);
    xcd_barrier(bar);
    GEMM_PHASE(pg8::EpiSwiGLU, U, (bf16*)(ws + WS_WGU + al((size_t)NGU * D * 2)), NGU, D, D, D, 0, (pg8::EpiSwiGLU{HMID, FF, 0}));
    xcd_barrier(bar);
    GEMM_PHASE(pg8::EpiF32, HMID, (bf16*)(ws + WS_WDN + al((size_t)D * FF * 2)), D, FF, FF, FF, 0, (pg8::EpiF32{OUTF, D, 0}));
    xcd_barrier(bar);
    rowpass_phase(in[I_XP], in[I_XS], Y, OUTF, in[I_GFFNPOST] + D, nullptr, Y, nullptr, nullptr, gw, ngw, lane);
#undef GEMM_PHASE
}

extern "C" void kernel_launch(void* const* d_in, const int* in_sizes, int n_in, void* d_out, int out_size, void* d_ws, size_t ws_size, hipStream_t stream) {
    static int grid = 0;
    if (grid == 0) {
        if (n_in != N_IN || (size_t)out_size != O_END || ws_size < WS_END) {
            fprintf(stderr, "kernel_launch: unexpected sizes n_in %d out %d ws %zu (need %zu)\n", n_in, out_size, ws_size, (size_t)WS_END); grid = -1; return; }
        int dev = 0, cus = 0, per_cu = 0;
        if (hipGetDevice(&dev) != hipSuccess || hipDeviceGetAttribute(&cus, hipDeviceAttributeMultiprocessorCount, dev) != hipSuccess) { grid = -1; return; }
        if (hipFuncSetAttribute((const void*)mega_fwd, hipFuncAttributeMaxDynamicSharedMemorySize, LDS_BYTES) != hipSuccess) { fprintf(stderr, "kernel_launch: hipFuncSetAttribute failed\n"); grid = -1; return; }
        if (hipOccupancyMaxActiveBlocksPerMultiprocessor(&per_cu, (const void*)mega_fwd, NTHREADS, LDS_BYTES) != hipSuccess || per_cu < 1) {
            fprintf(stderr, "kernel_launch: occupancy query says %d blocks per CU; need 1\n", per_cu); grid = -1; (void)hipGetLastError(); return; }
        grid = cus;
        if (grid != 256) fprintf(stderr, "kernel_launch: note: %d CUs (tuned for 256)\n", grid);
    }
    if (grid < 0) return;
    (void)hipMemsetAsync((char*)d_ws + cfg::WS_CTL, 0, CTL_ZERO_BYTES, stream);
    Args a; memset(&a, 0, sizeof(a));
    for (int i = 0; i < N_IN; ++i) a.in[i] = (const float*)d_in[i];
    a.out = (float*)d_out; a.ws = (unsigned char*)d_ws;
    void* kargs[] = {&a};
    hipError_t e = hipLaunchCooperativeKernel((const void*)mega_fwd, dim3(grid), dim3(NTHREADS), kargs, LDS_BYTES, stream);
    if (e != hipSuccess) fprintf(stderr, "kernel_launch: cooperative launch failed: %s (grid %d)\n", hipGetErrorString(e), grid);
}
```

```cpp
#include <hip/hip_runtime.h>
#include <cstdio>
#include <cstring>
#include <cstdint>
namespace pg8 {
#define PG8_LAS __attribute__((address_space(3)))
typedef unsigned short bf16_t;
typedef short bf16x8 __attribute__((ext_vector_type(8)));
typedef float f32x4 __attribute__((ext_vector_type(4)));
typedef float f32x2 __attribute__((ext_vector_type(2)));
typedef unsigned u32x4 __attribute__((ext_vector_type(4)));
constexpr int BM = 256, BK = 64, HALF = 128, HTB = HALF * BK * 2  , STAGE_BYTES = 8 * HTB, NXCD = 8, WGM = 8;

__host__ __device__ __forceinline__ int lds_byte(int r, int c) { const int st = (r >> 4) * 2 + (c >> 5), rr = r & 15, cc = c & 31, ob = rr * 64 + cc * 2; return st * 1024 + (ob ^ (((ob >> 9) & 1) << 5)); }
__host__ __device__ __forceinline__ void stage_rc(int b, int& R, int& C) { const int st = b / 1024, sb = b % 1024, swz = sb ^ (((sb >> 9) & 1) << 5); R = (st >> 1) * 16 + swz / 64; C = (st & 1) * 32 + (swz % 64) / 2; }
__host__ __device__ __forceinline__ int perm32(int rho) { const int n = rho >> 4, i = rho & 15; return 8 * (i >> 2) + 4 * n + (i & 3); }

struct Unit { int pm, pn, ks; };
struct Gemm { const bf16_t* A; const bf16_t* Bt; int M, N, K, lda, ldb, a_pn_off, ksl, pad; };

struct StaticOrder {
    int nM, nN, nwg, G, c;
    __host__ __device__ void init(int M, int N, int G_, int c_) { nM = M / BM; nN = N / BM; nwg = nM * nN; G = G_; c = c_; }
    __host__ __device__ bool next(int i, Unit& u) const {
        const long L = (long)i * G + c; if (L >= nwg) return false;
        int wgid = (int)L; { const int q = nwg / NXCD, r = nwg % NXCD, xcd = wgid % NXCD, off = wgid / NXCD; wgid = (xcd < r ? xcd * (q + 1) : r * (q + 1) + (xcd - r) * q) + off; }
        const int nig = WGM * nN, gid = wgid / nig, fm = gid * WGM, gsz = (nM - fm) < WGM ? (nM - fm) : WGM;
        u.pm = fm + ((wgid % nig) % gsz); u.pn = (wgid % nig) / gsz; u.ks = 0; return true;
    }
    __device__ __forceinline__ void a_ready(const Unit&) const {}
    __device__ __forceinline__ void done(const Unit&) const {}
};

struct SliceOrder {
    int nN, nks, G, c, pm;
    __device__ __forceinline__ bool next(int i, Unit& u) const { const int L = i * G + c; if (L >= nN * nks) return false; u.pm = pm; u.pn = L % nN; u.ks = L / nN; return true; }
    __device__ __forceinline__ void a_ready(const Unit&) const {}
    __device__ __forceinline__ void done(const Unit&) const {}
};

__device__ __forceinline__ unsigned cvt_pk_bf16(float lo, float hi) { unsigned r; asm volatile("v_cvt_pk_bf16_f32 %0, %1, %2" : "=v"(r) : "v"(lo), "v"(hi)); return r; }

struct EpiF32 {
    static constexpr bool PERM = false, AFTER_DRAIN = false;
    float* C; int ldc, pad;
    __device__ __forceinline__ void operator()(const f32x4 (&acc)[2][2][4][2], const Unit& u, int wr, int wc, int fr, int fq) const {
        const int row0 = u.pm * BM + wr * 64 + fr, col0 = u.pn * BM + wc * 32 + 4 * fq;
#pragma unroll
        for (int ai = 0; ai < 2; ++ai)
#pragma unroll
            for (int m = 0; m < 4; ++m) { float* rowp = C + (size_t)(row0 + ai * HALF + m * 16) * ldc + col0;
#pragma unroll
                for (int bj = 0; bj < 2; ++bj)
#pragma unroll
                    for (int n = 0; n < 2; ++n) *(f32x4*)(rowp + bj * HALF + n * 16) = acc[ai][bj][m][n]; }
    }
};
struct EpiSlab {
    static constexpr bool PERM = false, AFTER_DRAIN = false;
    float* S; int ldc, pad;
    __device__ __forceinline__ void operator()(const f32x4 (&acc)[2][2][4][2], const Unit& u, int wr, int wc, int fr, int fq) const {
        const int row0 = wr * 64 + fr, col0 = u.pn * BM + wc * 32 + 4 * fq;
#pragma unroll
        for (int m = 0; m < 4; ++m) { float* rowp = S + ((size_t)u.ks * HALF + row0 + m * 16) * ldc + col0;
#pragma unroll
            for (int bj = 0; bj < 2; ++bj)
#pragma unroll
                for (int n = 0; n < 2; ++n) *(f32x4*)(rowp + bj * HALF + n * 16) = acc[0][bj][m][n]; }
    }
};
struct EpiBf16 {
    static constexpr bool PERM = true, AFTER_DRAIN = false;
    bf16_t* O; int ldc, pad;
    __device__ __forceinline__ void operator()(const f32x4 (&acc)[2][2][4][2], const Unit& u, int wr, int wc, int fr, int fq) const {
        const int row0 = u.pm * BM + wr * 64 + fr; const int col0 = u.pn * BM + wc * 32 + 8 * fq;
#pragma unroll
        for (int ai = 0; ai < 2; ++ai)
#pragma unroll
            for (int m = 0; m < 4; ++m) { bf16_t* rowp = O + (size_t)(row0 + ai * HALF + m * 16) * ldc + col0;
#pragma unroll
                for (int bj = 0; bj < 2; ++bj) { const f32x4 v0 = acc[ai][bj][m][0], v1 = acc[ai][bj][m][1];
                    u32x4 w; w.x = cvt_pk_bf16(v0[0], v0[1]); w.y = cvt_pk_bf16(v0[2], v0[3]); w.z = cvt_pk_bf16(v1[0], v1[1]); w.w = cvt_pk_bf16(v1[2], v1[3]);
                    *(u32x4*)(rowp + bj * HALF) = w; } }
    }
};
__device__ __forceinline__ float silu_f(float x) { return x * __builtin_amdgcn_rcpf(1.0f + __expf(-x)); }
struct EpiSwiGLU {
    static constexpr bool PERM = true, AFTER_DRAIN = false;
    bf16_t* O; int ldc, pad;
    __device__ __forceinline__ void operator()(const f32x4 (&acc)[2][2][4][2], const Unit& u, int wr, int wc, int fr, int fq) const {
        const int row0 = u.pm * BM + wr * 64 + fr; const int col0 = u.pn * HALF + wc * 32 + 8 * fq;
#pragma unroll
        for (int ai = 0; ai < 2; ++ai)
#pragma unroll
            for (int m = 0; m < 4; ++m) { bf16_t* rowp = O + (size_t)(row0 + ai * HALF + m * 16) * ldc + col0;
                const f32x4 g0 = acc[ai][0][m][0], g1 = acc[ai][0][m][1], u0 = acc[ai][1][m][0], u1 = acc[ai][1][m][1];
                float h[8];
#pragma unroll
                for (int j = 0; j < 4; ++j) { h[j] = silu_f(g0[j]) * u0[j]; h[4 + j] = silu_f(g1[j]) * u1[j]; }
                u32x4 w; w.x = cvt_pk_bf16(h[0], h[1]); w.y = cvt_pk_bf16(h[2], h[3]); w.z = cvt_pk_bf16(h[4], h[5]); w.w = cvt_pk_bf16(h[6], h[7]);
                *(u32x4*)rowp = w; }
    }
};

template <class Epi, class Sched, bool ALIGN_EPI = false, bool SP2 = false>
__device__ __forceinline__ void gemm_phase(PG8_LAS unsigned char* lds, const Gemm g, const Sched& S, const Epi& E) {
    const int tid = threadIdx.x, wid = __builtin_amdgcn_readfirstlane(tid >> 6), lane = tid & 63, wr = wid >> 2, wc = wid & 3, fr = lane & 15, fq = lane >> 4;
    const int K = g.K, nt = K / BK;
    unsigned voffA[2], voffB[2];
#pragma unroll
    for (int i = 0; i < 2; ++i) { int R, C; stage_rc(tid * 16 + i * 8192, R, C); const int Rb = Epi::PERM ? ((R & ~31) + perm32(R & 31)) : R;
        voffA[i] = (unsigned)(R * g.lda + C) * 2u; voffB[i] = (unsigned)(Rb * g.ldb + C) * 2u; }
    const size_t kstep = (size_t)(BK * 2);
    const size_t hstepA = (size_t)HALF * g.lda * 2, hstepB = (size_t)HALF * g.ldb * 2;
    const size_t tstepA = 2 * hstepA, tstepB = 2 * hstepB;
    const size_t pnoffA = (size_t)g.a_pn_off * 2, ksoff = (size_t)g.ksl * 2;
    const unsigned ldsw = (unsigned)wid * 1024u;
    const int aoff = lds_byte(wr * 64 + fr, fq * 8), boff = lds_byte(wc * 32 + fr, fq * 8);
#define PG8_SA(b, h) (((b) * 2 + (h)) * HTB)
#define PG8_SB(b, h) ((4 + (b) * 2 + (h)) * HTB)
#define PG8_STAGE(bufoff, gbase, voff) do { _Pragma("unroll") for (int _i = 0; _i < 2; ++_i) \
        __builtin_amdgcn_global_load_lds((const unsigned*)((const char*)(gbase) + (voff)[_i]), (PG8_LAS unsigned*)(lds + (bufoff) + ldsw + _i * 8192), 16, 0, 0); } while (0)
#define PG8_LDA(dst, b, h) do { _Pragma("unroll") for (int m = 0; m < 4; ++m) _Pragma("unroll") for (int k = 0; k < 2; ++k) dst[m][k] = *(const PG8_LAS bf16x8*)(lds + PG8_SA(b, h) + aoff + m * 2048 + k * 1024); } while (0)
#define PG8_LDB(dst, b, h) do { _Pragma("unroll") for (int n = 0; n < 2; ++n) _Pragma("unroll") for (int k = 0; k < 2; ++k) dst[n][k] = *(const PG8_LAS bf16x8*)(lds + PG8_SB(b, h) + boff + n * 2048 + k * 1024); } while (0)
#define PG8_MMA(ai, bj, At, Bt) do { __builtin_amdgcn_s_setprio(1); _Pragma("unroll") for (int m = 0; m < 4; ++m) _Pragma("unroll") for (int n = 0; n < 2; ++n) _Pragma("unroll") for (int k = 0; k < 2; ++k) \
        acc[ai][bj][m][n] = __builtin_amdgcn_mfma_f32_16x16x32_bf16(Bt[n][k], At[m][k], acc[ai][bj][m][n], 0, 0, 0); __builtin_amdgcn_s_setprio(0); } while (0)
#define PG8_WAIT_V(n) asm volatile("s_waitcnt vmcnt(" #n ")" ::: "memory")
#define PG8_WAIT_L(n) asm volatile("s_waitcnt lgkmcnt(" #n ")" ::: "memory")
#define PG8_BAR __builtin_amdgcn_s_barrier()
#define PG8_SCHED __builtin_amdgcn_sched_barrier(0)
    Unit cur, nxt; int ui = 0;
    if (!S.next(0, cur)) return;
    f32x4 acc[2][2][4][2];
#pragma unroll
    for (int a = 0; a < 2; ++a)
#pragma unroll
        for (int b = 0; b < 2; ++b)
#pragma unroll
            for (int m = 0; m < 4; ++m)
#pragma unroll
                for (int n = 0; n < 2; ++n) acc[a][b][m][n] = (f32x4){0.f, 0.f, 0.f, 0.f};
    bf16x8 At[4][2], B0[2][2], B1[2][2];
    const char* cA = (const char*)g.A + (size_t)cur.pm * tstepA + (size_t)cur.pn * pnoffA + (size_t)cur.ks * ksoff; const char* cB = (const char*)g.Bt + (size_t)cur.pn * tstepB + (size_t)cur.ks * ksoff;
    S.a_ready(cur);
    if constexpr (SP2) {
        PG8_STAGE(PG8_SB(0, 0), cB, voffB); PG8_STAGE(PG8_SB(0, 1), cB + hstepB, voffB); PG8_STAGE(PG8_SA(0, 0), cA, voffA); PG8_STAGE(PG8_SA(0, 1), cA + hstepA, voffA);
        if (wr == 1) PG8_BAR;
        PG8_WAIT_V(2); PG8_BAR;
        PG8_STAGE(PG8_SB(1, 0), cB + kstep, voffB); PG8_STAGE(PG8_SA(1, 0), cA + kstep, voffA); PG8_STAGE(PG8_SB(1, 1), cB + hstepB + kstep, voffB);
        PG8_WAIT_V(6); PG8_BAR;
    } else {
        PG8_STAGE(PG8_SB(0, 0), cB, voffB); PG8_STAGE(PG8_SA(0, 0), cA, voffA); PG8_STAGE(PG8_SB(0, 1), cB + hstepB, voffB); PG8_STAGE(PG8_SA(0, 1), cA + hstepA, voffA);
        if (wr == 1) PG8_BAR;
        PG8_WAIT_V(4); PG8_BAR;
        PG8_STAGE(PG8_SB(1, 0), cB + kstep, voffB); PG8_STAGE(PG8_SA(1, 0), cA + kstep, voffA); PG8_STAGE(PG8_SB(1, 1), cB + hstepB + kstep, voffB);
        PG8_WAIT_V(6); PG8_BAR;
    }
    for (;;) {
        const bool has_next = S.next(ui + 1, nxt);
        const char* nA = has_next ? (const char*)g.A + (size_t)nxt.pm * tstepA + (size_t)nxt.pn * pnoffA + (size_t)nxt.ks * ksoff : cA; const char* nB = has_next ? (const char*)g.Bt + (size_t)nxt.pn * tstepB + (size_t)nxt.ks * ksoff : cB;
        for (int t = 0; t < nt; t += 2) {
            const bool last = (t == nt - 2);
            const char* a1 = cA + (size_t)(t + 1) * kstep;
            const char* a2 = last ? nA : cA + (size_t)(t + 2) * kstep; const char* b2 = last ? nB : cB + (size_t)(t + 2) * kstep;
            const char* a3 = a2 + kstep; const char* b3 = b2 + kstep;
            if (last && has_next) S.a_ready(nxt);
            if constexpr (SP2) {
            PG8_LDB(B0, 0, 0); PG8_LDB(B1, 0, 1); PG8_SCHED; PG8_LDA(At, 0, 0); PG8_STAGE(PG8_SA(1, 1), a1 + hstepA, voffA);
            PG8_WAIT_V(8); PG8_WAIT_L(0); PG8_BAR; PG8_MMA(0, 0, At, B0); PG8_MMA(0, 1, At, B1); PG8_BAR; PG8_SCHED;
            PG8_LDA(At, 0, 1); PG8_STAGE(PG8_SB(0, 0), b2, voffB); PG8_STAGE(PG8_SB(0, 1), b2 + hstepB, voffB); PG8_STAGE(PG8_SA(0, 0), a2, voffA);
            PG8_WAIT_V(8); PG8_WAIT_L(0); PG8_BAR; PG8_MMA(1, 0, At, B0); PG8_MMA(1, 1, At, B1); PG8_BAR; PG8_SCHED;
            PG8_LDB(B0, 1, 0); PG8_LDB(B1, 1, 1); PG8_SCHED; PG8_LDA(At, 1, 0); PG8_STAGE(PG8_SA(0, 1), a2 + hstepA, voffA);
            PG8_WAIT_V(8); PG8_WAIT_L(0); PG8_BAR; PG8_MMA(0, 0, At, B0); PG8_MMA(0, 1, At, B1); PG8_BAR; PG8_SCHED;
            PG8_LDA(At, 1, 1); PG8_STAGE(PG8_SB(1, 0), b3, voffB); PG8_STAGE(PG8_SB(1, 1), b3 + hstepB, voffB); PG8_STAGE(PG8_SA(1, 0), a3, voffA);
            PG8_WAIT_V(8); PG8_WAIT_L(0); PG8_BAR; PG8_MMA(1, 0, At, B0); PG8_MMA(1, 1, At, B1); PG8_BAR; PG8_SCHED;
            } else {
            PG8_LDB(B0, 0, 0); PG8_SCHED; PG8_LDA(At, 0, 0); PG8_STAGE(PG8_SA(1, 1), a1 + hstepA, voffA);
            PG8_WAIT_L(8); PG8_BAR; PG8_WAIT_L(0); PG8_MMA(0, 0, At, B0); PG8_BAR; PG8_SCHED;
            PG8_LDB(B1, 0, 1); PG8_STAGE(PG8_SB(0, 0), b2, voffB);
            PG8_BAR; PG8_WAIT_L(0); PG8_MMA(0, 1, At, B1); PG8_BAR;
            PG8_LDA(At, 0, 1); PG8_STAGE(PG8_SA(0, 0), a2, voffA);
            PG8_BAR; PG8_WAIT_L(0); PG8_MMA(1, 0, At, B0); PG8_BAR; PG8_SCHED;
            PG8_STAGE(PG8_SB(0, 1), b2 + hstepB, voffB);
            PG8_WAIT_V(6); PG8_BAR; PG8_MMA(1, 1, At, B1); PG8_BAR;
            PG8_LDB(B0, 1, 0); PG8_SCHED; PG8_LDA(At, 1, 0); PG8_STAGE(PG8_SA(0, 1), a2 + hstepA, voffA);
            PG8_WAIT_L(8); PG8_BAR; PG8_WAIT_L(0); PG8_MMA(0, 0, At, B0); PG8_BAR; PG8_SCHED;
            PG8_LDB(B1, 1, 1); PG8_STAGE(PG8_SB(1, 0), b3, voffB);
            PG8_BAR; PG8_WAIT_L(0); PG8_MMA(0, 1, At, B1); PG8_BAR;
            PG8_LDA(At, 1, 1); PG8_STAGE(PG8_SA(1, 0), a3, voffA);
            PG8_BAR; PG8_WAIT_L(0); PG8_MMA(1, 0, At, B0); PG8_BAR; PG8_SCHED;
            PG8_STAGE(PG8_SB(1, 1), b3 + hstepB, voffB);
            PG8_WAIT_V(6); PG8_BAR; PG8_MMA(1, 1, At, B1); PG8_BAR;
            }
        }
        if constexpr (ALIGN_EPI) { if (wr == 0) PG8_BAR; }
        if constexpr (!Epi::AFTER_DRAIN) { E(acc, cur, wr, wc, fr, fq); S.done(cur); }
        if (!has_next) break;
#pragma unroll
        for (int a = 0; a < 2; ++a)
#pragma unroll
            for (int b = 0; b < 2; ++b)
#pragma unroll
                for (int m = 0; m < 4; ++m)
#pragma unroll
                    for (int n = 0; n < 2; ++n) acc[a][b][m][n] = (f32x4){0.f, 0.f, 0.f, 0.f};
        cur = nxt; cA = nA; cB = nB; ++ui;
        if constexpr (ALIGN_EPI) { if (wr == 1) PG8_BAR; }
    }
    PG8_WAIT_V(0);
    if constexpr (!ALIGN_EPI) { if (wr == 0) PG8_BAR; }
    PG8_BAR;
    if constexpr (Epi::AFTER_DRAIN) { E.fused(acc, cur, wr, wc, fr, fq, lds, wid, lane); S.done(cur); }
#undef PG8_SA
#undef PG8_SB
#undef PG8_STAGE
#undef PG8_LDA
#undef PG8_LDB
#undef PG8_MMA
#undef PG8_WAIT_V
#undef PG8_WAIT_L
#undef PG8_BAR
#undef PG8_SCHED
}
}
namespace cfg {
constexpr int D = 1024, BATCH = 8, SEQ = 2048, MP = BATCH * SEQ, MS = 128, MR = MP + MS, MPAD = 16640;
constexpr int MH = 4, MDK = 256, MDV = 256;
constexpr int SH = 16, SP = 64, SG = 2, SN = 128, CONVD = 1536;
constexpr int INDIM = 6680, NIN = 6912, FF = 2816, NGU = 2 * FF, MIX = 2048;
constexpr float EPS = 1e-6f, GATE_CAP = 15.0f;
constexpr int PQ = 0, PK = 1024, PV = 2048, PO = 3072, PZ = 4096, PX = 5120, PG = 6656;
constexpr int GW = 40;
enum { I_XP = 0, I_XS, I_SC, I_SN, I_SM, I_SSSM, I_SCONV, I_SPOOL, I_GMIXPRE, I_GMIXPOST, I_GFFNPRE, I_GFFNPOST, I_WIN, I_BIG, I_BFG, I_GMLSTM,
       I_CONVW, I_CONVB, I_DTBIAS, I_ALOG, I_DSKIP, I_GSSM, I_WOUT, I_WPOOL, I_POOLSCALE, I_WGATE, I_WUP, I_WDOWN, N_IN };
constexpr size_t O_Y = 0;
constexpr size_t O_CP = O_Y + (size_t)MR * D;
constexpr size_t O_CS = O_CP + (size_t)BATCH * MH * MDK * MDV;
constexpr size_t O_NP = O_CS + (size_t)MS * MH * MDK * MDV;
constexpr size_t O_NS = O_NP + (size_t)BATCH * MH * MDK;
constexpr size_t O_MP = O_NS + (size_t)MS * MH * MDK;
constexpr size_t O_MS = O_MP + (size_t)BATCH * MH;
constexpr size_t O_SSP = O_MS + (size_t)MS * MH;
constexpr size_t O_SSS = O_SSP + (size_t)BATCH * SH * SP * SN;
constexpr size_t O_CVP = O_SSS + (size_t)MS * SH * SP * SN;
constexpr size_t O_CVS = O_CVP + (size_t)BATCH * 3 * CONVD;
constexpr size_t O_PLP = O_CVS + (size_t)MS * 3 * CONVD;
constexpr size_t O_PLS = O_PLP + (size_t)BATCH * 15 * D;
constexpr size_t O_END = O_PLS + (size_t)MS * 15 * D;
static_assert(O_END == 73241120, "output size");
constexpr size_t al(size_t x) { return (x + 4095) & ~(size_t)4095; }
constexpr size_t WS_CTL = 0, CTL_BYTES = 1u << 20;
constexpr size_t WS_WIN = WS_CTL + CTL_BYTES;
constexpr size_t WS_WOUT = WS_WIN + al((size_t)NIN * D * 2);
constexpr size_t WS_WGU = WS_WOUT + al((size_t)D * MIX * 2);
constexpr size_t WS_WDN = WS_WGU + 2 * al((size_t)NGU * D * 2);
constexpr size_t WS_WPOOL = WS_WDN + 2 * al((size_t)D * FF * 2);
constexpr size_t WS_U = WS_WPOOL + al((size_t)D * 256 * 2);
constexpr size_t WS_G = WS_U + al((size_t)MPAD * D * 2);
constexpr size_t WS_XC = WS_G + al((size_t)MR * GW * 4);
constexpr size_t WS_HY = WS_XC + al((size_t)MR * CONVD * 2);
constexpr size_t WS_SLAB = WS_HY + al((size_t)MPAD * MIX * 2);
constexpr size_t WS_PROJ = WS_SLAB + al((size_t)11 * 128 * D * 4);
constexpr size_t WS_OUTF = WS_PROJ;
constexpr size_t WS_HMID = WS_OUTF + al((size_t)MPAD * D * 4);
constexpr size_t WS_U2F = WS_HMID + al((size_t)MPAD * FF * 2);
constexpr size_t WS_END0 = WS_PROJ + al((size_t)MPAD * NIN * 2);
constexpr size_t WS_END1 = WS_U2F + al((size_t)MR * D * 4);
constexpr size_t WS_END = WS_END0 > WS_END1 ? WS_END0 : WS_END1;
}

typedef unsigned short bf16;
#define LAS __attribute__((address_space(3)))
typedef float f32x4 __attribute__((ext_vector_type(4)));
typedef unsigned u32x4 __attribute__((ext_vector_type(4)));
typedef unsigned u32x2 __attribute__((ext_vector_type(2)));

__device__ __forceinline__ unsigned f2bf(float f) { unsigned u = __builtin_bit_cast(unsigned, f); return (u + 0x7fffu + ((u >> 16) & 1u)) >> 16; }
__device__ __forceinline__ unsigned pk2(float lo, float hi) { return f2bf(lo) | (f2bf(hi) << 16); }
__device__ __forceinline__ float bf2f(unsigned short b) { return __builtin_bit_cast(float, (unsigned)b << 16); }
__device__ __forceinline__ float bflo(unsigned w) { return __builtin_bit_cast(float, w << 16); }
__device__ __forceinline__ float bfhi(unsigned w) { return __builtin_bit_cast(float, w & 0xffff0000u); }
__device__ __forceinline__ f32x4 ld_bf4(const bf16* p) { const u32x2 w = *(const u32x2*)p; return (f32x4){bflo(w.x), bfhi(w.x), bflo(w.y), bfhi(w.y)}; }
__device__ __forceinline__ void st_bf4(bf16* p, f32x4 v) { u32x2 w; w.x = pk2(v.x, v.y); w.y = pk2(v.z, v.w); *(u32x2*)p = w; }
__device__ __forceinline__ float wave_sum(float v) {
#pragma unroll
    for (int o = 1; o < 64; o <<= 1) v += __shfl_xor(v, o);
    return v;
}
__device__ __forceinline__ float sigmoid_f(float x) { return 1.0f / (1.0f + expf(-x)); }
__device__ __forceinline__ float silu_x(float x) { return x / (1.0f + expf(-x)); }
__device__ __forceinline__ float softplus_f(float x) { return fmaxf(x, 0.f) + log1pf(expf(-fabsf(x))); }
__device__ __forceinline__ float softcap_f(float x) { return cfg::GATE_CAP * tanhf(x * (1.0f / cfg::GATE_CAP)); }
constexpr int NWAVES = 8, NTHREADS = NWAVES * 64;
constexpr int RING_OFF = 0, RING_BYTES = 139264;
constexpr int LDSCTL_OFF = RING_BYTES, MISC_OFF = LDSCTL_OFF + 320;
constexpr int LDS_BYTES = 147456;
constexpr int CW_TMO = 0, CW_CODE = 1, CW_BAR = 4096, CTL_ZERO_BYTES = 65536;
#define GAS __attribute__((address_space(1)))
typedef GAS unsigned gu32;
#define RLX_AGENT __ATOMIC_RELAXED, __HIP_MEMORY_SCOPE_AGENT

#define XB_TMO      128
#define XB_XCNT(j)  (256  + 64 * (j))
#define XB_XSUB(j)  (1280 + 64 * (j))
#define XB_XGEN(j)  (2304 + 64 * (j))
#define XB_TOP      3328
#define XB_TOPGEN   3392
#define XCD_BAR_WORDS 3456
#define XB_SPIN_CAP (1u << 22)
static_assert((CW_BAR + XCD_BAR_WORDS) * 4 <= CTL_ZERO_BYTES, "barrier words inside the memset region");

__device__ __forceinline__ unsigned xb_ld(unsigned* p)              { return __hip_atomic_load(p, __ATOMIC_RELAXED, __HIP_MEMORY_SCOPE_AGENT); }
__device__ __forceinline__ unsigned xb_add(unsigned* p, unsigned v) { return __hip_atomic_fetch_add(p, v, __ATOMIC_RELAXED, __HIP_MEMORY_SCOPE_AGENT); }
__device__ __forceinline__ unsigned xb_xcc_id() { return (unsigned)__builtin_amdgcn_s_getreg((3 << 11) | 20) & 0xFu; }
#define XB_SPIN(cond, bar) do { unsigned _sp = 0; while (cond) { __builtin_amdgcn_s_sleep(1); \
    if ((++_sp & 255u) == 0u) { if (xb_ld(&(bar)[XB_TMO])) break; if (_sp > XB_SPIN_CAP) { atomicAdd(&(bar)[XB_TMO], 1u); break; } } } } while (0)

struct XcdBarrier {
    unsigned* bar; unsigned x;
    volatile LAS unsigned* st;
};
__device__ __forceinline__ XcdBarrier xcd_barrier_post(unsigned* bar, volatile LAS unsigned* st) {
    XcdBarrier b; b.bar = bar; b.x = xb_xcc_id(); b.st = st;
    if (threadIdx.x == 0) (void)xb_add(&bar[XB_XCNT(b.x)], 1u);
    return b;
}
__device__ __forceinline__ void xcd_barrier_complete(unsigned* bar, unsigned x, unsigned& nloc, unsigned& nx) {
    const unsigned G = gridDim.x * gridDim.y * gridDim.z;
    unsigned sum, cnt, mine, sp = 0u;
    for (;;) {
        sum = 0u; cnt = 0u; mine = 0u;
#pragma unroll
        for (unsigned j = 0; j < 16; ++j) { const unsigned c = xb_ld(&bar[XB_XCNT(j)]); sum += c; cnt += (c > 0u) ? 1u : 0u; mine = (j == x) ? c : mine; }
        if (sum == G) break;
        __builtin_amdgcn_s_sleep(1);
        if ((++sp & 255u) == 0u) { if (xb_ld(&bar[XB_TMO])) break; if (sp > XB_SPIN_CAP) { atomicAdd(&bar[XB_TMO], 1u); break; } }
    }
    nloc = mine > 0u ? mine : 1u; nx = cnt > 0u ? cnt : 1u;
}
__device__ __forceinline__ void xcd_barrier(const XcdBarrier& b) {
    asm volatile("s_waitcnt vmcnt(0)" ::: "memory");
    __syncthreads();
    if (threadIdx.x == 0) {
        unsigned* bar = b.bar;
        __builtin_amdgcn_s_waitcnt(0);
        unsigned nloc = b.st[0], nx = b.st[1];
        if (nloc == 0u) { xcd_barrier_complete(bar, b.x, nloc, nx); b.st[0] = nloc; b.st[1] = nx; }
        const unsigned old = xb_add(&bar[XB_XSUB(b.x)], 1u);
        const unsigned gen = old / nloc;
        if (old + 1u == (gen + 1u) * nloc) {
            __builtin_amdgcn_fence(__ATOMIC_RELEASE, "agent");
            asm volatile("s_waitcnt vmcnt(0)" ::: "memory");
            const unsigned og = xb_add(&bar[XB_TOP], 1u);
            const unsigned tg = og / nx;
            if (og + 1u == (tg + 1u) * nx) xb_add(&bar[XB_TOPGEN], 1u);
            else XB_SPIN(xb_ld(&bar[XB_TOPGEN]) == tg, bar);
            __builtin_amdgcn_fence(__ATOMIC_ACQUIRE, "agent");
            xb_add(&bar[XB_XGEN(b.x)], 1u);
            asm volatile("s_waitcnt vmcnt(0)" ::: "memory");
        } else {
            XB_SPIN(xb_ld(&bar[XB_XGEN(b.x)]) == gen, bar);
            __builtin_amdgcn_fence(__ATOMIC_ACQUIRE, "agent");
            asm volatile("s_waitcnt vmcnt(0)" ::: "memory");
        }
    }
    __syncthreads();
}
using namespace cfg;
struct PrepMat { const float* W0; const float* W1; const float* scale; bf16* WT; int ldw, K, N, mode, nitems, pad; };
__device__ __forceinline__ void prep_item(const PrepMat& P, int item, LAS float* scr, int lane) {
    const int nblk = P.N / 32, kb = item / nblk, nb = item % nblk, k0 = 64 * kb, n0 = 32 * nb;
    const int n = n0 + (lane & 31);
    const float* W = P.W0; int sc = n; float mul = 1.0f;
    if (P.mode == 1) {
        if (n < 4096) { sc = n; if (n < 1024) mul = 0.0625f; }
        else if (n < 5120) sc = 4104 + (n - 4096);
        else if (n < 6656) sc = 5128 + (n - 5120);
        else if (n < 6664) sc = 4096 + (n - 6656);
        else if (n < 6680) sc = n;
        else sc = -1;
    } else if (P.mode == 2) {
        const int pn = n >> 8, w = n & 255; W = (w < 128) ? P.W0 : P.W1; sc = 128 * pn + (w & 127);
    } else if (P.mode == 3) {
        mul = P.scale[n];
    }
#pragma unroll 8
    for (int i = 0; i < 32; ++i) { const int kk = 2 * i + (lane >> 5); scr[kk * 33 + (lane & 31)] = (sc >= 0) ? W[(size_t)(k0 + kk) * P.ldw + sc] * mul : 0.f; }
    asm volatile("s_waitcnt lgkmcnt(0)" ::: "memory");
    const int c = lane & 7;
#pragma unroll
    for (int j = 0; j < 4; ++j) { const int nn = (lane >> 3) + 8 * j; const LAS float* s = scr + (8 * c) * 33 + nn;
        u32x4 o; o.x = pk2(s[0 * 33], s[1 * 33]); o.y = pk2(s[2 * 33], s[3 * 33]); o.z = pk2(s[4 * 33], s[5 * 33]); o.w = pk2(s[6 * 33], s[7 * 33]);
        *(u32x4*)(P.WT + (size_t)(n0 + nn) * P.K + k0 + 8 * c) = o; }
    asm volatile("s_waitcnt lgkmcnt(0)" ::: "memory");
}
__device__ __forceinline__ PrepMat mk_mat(const float* W0, const float* W1, const float* scale, int ldw, int K, int N, int mode, bf16* WT) {
    PrepMat m; m.W0 = W0; m.W1 = W1; m.scale = scale; m.WT = WT; m.ldw = ldw; m.K = K; m.N = N; m.mode = mode; m.nitems = (K / 64) * (N / 32); m.pad = 0; return m;
}
constexpr int PI_IN = (D / 64) * (NIN / 32), PI_OUT = (MIX / 64) * (D / 32), PI_GU = (D / 64) * (NGU / 32), PI_DN = (FF / 64) * (D / 32), PI_PL = (256 / 64) * (256 / 32);
constexpr int PI_TOTAL = PI_IN + PI_OUT + 2 * PI_GU + 2 * PI_DN + 4 * PI_PL;
__device__ __forceinline__ void prep_phase(const float* const* in, unsigned char* ws, LAS float* scr, int gw, int ngw, int lane) {
    for (int it = gw; it < PI_TOTAL; it += ngw) {
        int r = it; PrepMat m;
        if (r < PI_IN) m = mk_mat(in[I_WIN], nullptr, nullptr, INDIM, D, NIN, 1, (bf16*)(ws + WS_WIN));
        else if ((r -= PI_IN) < PI_OUT) m = mk_mat(in[I_WOUT], nullptr, nullptr, D, MIX, D, 0, (bf16*)(ws + WS_WOUT));
        else if ((r -= PI_OUT) < 2 * PI_GU) { const int l = r / PI_GU; r -= l * PI_GU;
            m = mk_mat(in[I_WGATE] + (size_t)l * D * FF, in[I_WUP] + (size_t)l * D * FF, nullptr, FF, D, NGU, 2, (bf16*)(ws + WS_WGU + l * al((size_t)NGU * D * 2))); }
        else if ((r -= 2 * PI_GU) < 2 * PI_DN) { const int l = r / PI_DN; r -= l * PI_DN;
            m = mk_mat(in[I_WDOWN] + (size_t)l * FF * D, nullptr, nullptr, D, FF, D, 0, (bf16*)(ws + WS_WDN + l * al((size_t)D * FF * 2))); }
        else { r -= 2 * PI_DN; const int g = r / PI_PL; r -= g * PI_PL;
            m = mk_mat(in[I_WPOOL] + (size_t)g * 65536, nullptr, in[I_POOLSCALE] + g * 256, 256, 256, 256, 3, (bf16*)(ws + WS_WPOOL) + (size_t)g * 65536); }
        prep_item(m, r, scr, lane);
    }
}

__device__ __forceinline__ const float* x_row(const float* xp, const float* xs, int r) { return r < MP ? xp + (size_t)r * D : xs + (size_t)(r - MP) * D; }

__device__ __forceinline__ void norm0_phase(const float* xp, const float* xs, const float* g, bf16* U, int gw, int ngw, int lane) {
    for (int r = gw; r < MPAD; r += ngw) {
        bf16* o = U + (size_t)r * D;
        if (r >= MR) {
#pragma unroll
            for (int j = 0; j < 4; ++j) *(u32x2*)(o + 4 * lane + 256 * j) = (u32x2){0u, 0u};
            continue; }
        const float* x = x_row(xp, xs, r);
        f32x4 v[4]; float ss = 0.f;
#pragma unroll
        for (int j = 0; j < 4; ++j) { v[j] = *(const f32x4*)(x + 4 * lane + 256 * j); ss += v[j].x * v[j].x + v[j].y * v[j].y + v[j].z * v[j].z + v[j].w * v[j].w; }
        const float rstd = 1.0f / sqrtf(wave_sum(ss) * (1.0f / D) + EPS);
#pragma unroll
        for (int j = 0; j < 4; ++j) { const f32x4 gg = *(const f32x4*)(g + 4 * lane + 256 * j); st_bf4(o + 4 * lane + 256 * j, v[j] * rstd * gg); }
    }
}

__device__ __forceinline__ void conv_phase(const bf16* proj, const float* sconv, const float* cw, const float* cb, const float* big, const float* bfg,
                                           const float* dtb, const float* alog, bf16* XC, float* G, float* out, size_t t0, size_t nthr) {
    for (size_t i = t0; i < (size_t)(MP / 16) * (CONVD / 4); i += nthr) {
        const int c = 4 * (int)(i % (CONVD / 4)), r0 = 16 * (int)(i / (CONVD / 4)), tq = r0 & (SEQ - 1);
        f32x4 xv[19];
#pragma unroll
        for (int k = 0; k < 19; ++k) { if (k >= 3 || tq > 0) xv[k] = ld_bf4(proj + (size_t)(r0 - 3 + k) * NIN + PX + c); else xv[k] = (f32x4){0.f, 0.f, 0.f, 0.f}; }
        const f32x4 w0 = *(const f32x4*)(cw + c), w1 = *(const f32x4*)(cw + CONVD + c), w2 = *(const f32x4*)(cw + 2 * CONVD + c), w3 = *(const f32x4*)(cw + 3 * CONVD + c), bb = *(const f32x4*)(cb + c);
#pragma unroll
        for (int k = 0; k < 16; ++k) {
            const f32x4 acc = bb + xv[k] * w0 + xv[k + 1] * w1 + xv[k + 2] * w2 + xv[k + 3] * w3;
            f32x4 y; y.x = silu_x(acc.x); y.y = silu_x(acc.y); y.z = silu_x(acc.z); y.w = silu_x(acc.w);
            st_bf4(XC + (size_t)(r0 + k) * CONVD + c, y);
        }
    }
    for (size_t i = t0; i < (size_t)MS * (CONVD / 4); i += nthr) {
        const int b = (int)(i / (CONVD / 4)), c = 4 * (int)(i % (CONVD / 4)); const size_t r = (size_t)MP + b;
        f32x4 acc = *(const f32x4*)(cb + c);
#pragma unroll
        for (int j = 0; j < 3; ++j) acc += *(const f32x4*)(sconv + ((size_t)b * 3 + j) * CONVD + c) * *(const f32x4*)(cw + (size_t)j * CONVD + c);
        acc += ld_bf4(proj + r * NIN + PX + c) * *(const f32x4*)(cw + (size_t)3 * CONVD + c);
        f32x4 y; y.x = silu_x(acc.x); y.y = silu_x(acc.y); y.z = silu_x(acc.z); y.w = silu_x(acc.w);
        st_bf4(XC + r * CONVD + c, y);
    }
    for (size_t i = t0; i < (size_t)BATCH * 3 * (CONVD / 4); i += nthr) {
        const int c = 4 * (int)(i % (CONVD / 4)), j = (int)(i / (CONVD / 4)) % 3, b = (int)(i / (CONVD / 4)) / 3;
        *(f32x4*)(out + O_CVP + ((size_t)b * 3 + j) * CONVD + c) = ld_bf4(proj + (size_t)(b * SEQ + SEQ - 3 + j) * NIN + PX + c);
    }
    for (size_t i = t0; i < (size_t)MS * 3 * (CONVD / 4); i += nthr) {
        const int c = 4 * (int)(i % (CONVD / 4)), j = (int)(i / (CONVD / 4)) % 3, b = (int)(i / (CONVD / 4)) / 3;
        f32x4 v; if (j < 2) v = *(const f32x4*)(sconv + ((size_t)b * 3 + j + 1) * CONVD + c); else v = ld_bf4(proj + (size_t)(MP + b) * NIN + PX + c);
        *(f32x4*)(out + O_CVS + ((size_t)b * 3 + j) * CONVD + c) = v;
    }
    for (size_t i = t0; i < (size_t)MR * 24; i += nthr) {
        const int r = (int)(i / 24), k = (int)(i % 24);
        const float pre = bf2f(proj[(size_t)r * NIN + PG + k]);
        float* g = G + (size_t)r * GW;
        if (k < 4) g[k] = softcap_f(pre + big[k]);
        else if (k < 8) { const float x = softcap_f(pre + bfg[k - 4]); g[k] = fminf(x, 0.f) - log1pf(expf(-fabsf(x))); }
        else { const int hd = k - 8; const float dt = softplus_f(pre + dtb[hd]); g[8 + hd] = dt; g[24 + hd] = -dt * expf(alog[hd]); }
    }
}

constexpr int MLN_LDS_F = 4096 + 4096 + 512 + 4096 + 64 + 80 + 16;
__device__ __forceinline__ void mlstm_prompt_naive(const bf16* proj, const float* G, bf16* HY, float* out, int item, LAS float* L, int tid  ) {
    const int vs = item & 7, h = (item >> 3) & 3, b = item >> 5;
    const int dg = tid >> 5, vv = tid & 31, lane = tid & 63, wave = tid >> 6;
    LAS float* qs = L; LAS float* ks = L + 4096; LAS float* vsh = L + 8192; LAS float* pnum = L + 8704; LAS float* pqn = L + 12800;
    LAS float* mts = L + 12864; LAS float* decs = mts + 16; LAS float* wsh = mts + 32; LAS float* lis = mts + 48; LAS float* lfs = mts + 64; LAS float* mc = mts + 80;
    float c[32];
#pragma unroll
    for (int i = 0; i < 32; ++i) c[i] = 0.f;
    float nd = 0.f;
    if (tid == 0) mc[0] = 0.f;
    for (int t0 = 0; t0 < SEQ; t0 += 16) {
        __syncthreads();
        const size_t row0 = (size_t)b * SEQ + t0;
        for (int tt = 0; tt < 16; ++tt) {
            qs[tt * 256 + tid] = bf2f(proj[(row0 + tt) * NIN + PQ + h * 256 + tid]);
            ks[tt * 256 + tid] = bf2f(proj[(row0 + tt) * NIN + PK + h * 256 + tid]);
        }
        for (int e = tid; e < 16 * 32; e += 256) { const int tt = e >> 5, v = e & 31; vsh[e] = bf2f(proj[(row0 + tt) * NIN + PV + h * 256 + vs * 32 + v]); }
        if (tid < 16) { lis[tid] = G[(row0 + tid) * GW + h]; lfs[tid] = G[(row0 + tid) * GW + 4 + h]; }
        __syncthreads();
        if (tid == 0) {
            float m = mc[0];
            for (int tt = 0; tt < 16; ++tt) { const float li = lis[tt], lf = lfs[tt]; const float mn = fmaxf(lf + m, li); decs[tt] = expf(lf + m - mn); wsh[tt] = expf(li - mn); mts[tt] = mn; m = mn; }
            mc[0] = m;
        }
        __syncthreads();
        for (int tt = 0; tt < 16; ++tt) {
            const float dec = decs[tt], w = wsh[tt];
            const float vval = vsh[tt * 32 + vv] * w;
            float acc = 0.f;
#pragma unroll
            for (int i = 0; i < 32; ++i) { c[i] = dec * c[i] + ks[tt * 256 + dg * 32 + i] * vval; acc += qs[tt * 256 + dg * 32 + i] * c[i]; }
            pnum[(tt * 8 + dg) * 32 + vv] = acc;
            nd = dec * nd + w * ks[tt * 256 + tid];
            const float qn = wave_sum(qs[tt * 256 + tid] * nd);
            if (lane == 0) pqn[tt * 4 + wave] = qn;
        }
        __syncthreads();
#pragma unroll
        for (int rep = 0; rep < 2; ++rep) {
            const int tt = (tid >> 5) + 8 * rep;
            float num = 0.f;
#pragma unroll
            for (int g8 = 0; g8 < 8; ++g8) num += pnum[(tt * 8 + g8) * 32 + vv];
            const float den = (pqn[tt * 4 + 0] + pqn[tt * 4 + 1]) + (pqn[tt * 4 + 2] + pqn[tt * 4 + 3]);
            const float hval = num / fmaxf(fabsf(den), expf(-mts[tt]));
            HY[(row0 + tt) * MIX + h * 256 + vs * 32 + vv] = (bf16)f2bf(hval);
        }
    }
    __syncthreads();
#pragma unroll
    for (int i = 0; i < 32; ++i) out[O_CP + ((size_t)(b * MH + h) * MDK + dg * 32 + i) * MDV + vs * 32 + vv] = c[i];
    if (vs == 0) { out[O_NP + (size_t)(b * MH + h) * MDK + tid] = nd; if (tid == 0) out[O_MP + b * MH + h] = mc[0]; }
}

__device__ __forceinline__ void mlstm_sample_item(const bf16* proj, const float* G, const float* cin, const float* nin, const float* min_, bf16* HY, float* out, int item, LAS float* L, int tid) {
    const int h = item & 3, b = item >> 2, lane = tid & 63, wave = tid >> 6;
    const size_t row = (size_t)MP + b;
    LAS float* qs = L; LAS float* ks = L + 256; LAS float* red = L + 512; LAS float* qnr = L + 1536;
    __syncthreads();
    qs[tid] = bf2f(proj[row * NIN + PQ + h * 256 + tid]); ks[tid] = bf2f(proj[row * NIN + PK + h * 256 + tid]);
    const float li = G[row * GW + h], lf = G[row * GW + 4 + h], m = min_[b * MH + h];
    const float mn = fmaxf(lf + m, li), dec = expf(lf + m - mn), w = expf(li - mn);
    __syncthreads();
    const float nd = dec * nin[(size_t)(b * MH + h) * MDK + tid] + w * ks[tid];
    out[O_NS + (size_t)(b * MH + h) * MDK + tid] = nd;
    const float qn = wave_sum(qs[tid] * nd);
    if (lane == 0) qnr[wave] = qn;
    const int dq = tid >> 6, v4 = tid & 63;
    const f32x4 vv = ld_bf4(proj + row * NIN + PV + h * 256 + 4 * v4) * w;
    f32x4 acc = (f32x4){0.f, 0.f, 0.f, 0.f};
    const float* cbase = cin + ((size_t)(b * MH + h) * MDK) * MDV + 4 * v4;
    float* obase = out + O_CS + ((size_t)(b * MH + h) * MDK) * MDV + 4 * v4;
    for (int d = dq * 64; d < dq * 64 + 64; ++d) {
        const f32x4 c4 = *(const f32x4*)(cbase + (size_t)d * MDV);
        const f32x4 cn = c4 * dec + vv * ks[d];
        *(f32x4*)(obase + (size_t)d * MDV) = cn;
        acc += cn * qs[d];
    }
    red[dq * 256 + 4 * v4 + 0] = acc.x; red[dq * 256 + 4 * v4 + 1] = acc.y; red[dq * 256 + 4 * v4 + 2] = acc.z; red[dq * 256 + 4 * v4 + 3] = acc.w;
    __syncthreads();
    const float num = (red[tid] + red[256 + tid]) + (red[512 + tid] + red[768 + tid]);
    const float den = (qnr[0] + qnr[1]) + (qnr[2] + qnr[3]);
    HY[row * MIX + h * 256 + tid] = (bf16)f2bf(num / fmaxf(fabsf(den), expf(-mn)));
    if (tid == 0) out[O_MS + b * MH + h] = mn;
}

constexpr int SSN_LDS_F = 1024 + 2304 + 2304 + 32;
__device__ __forceinline__ void ssd_prompt_naive(const bf16* XC, const float* G, const float* dskip, bf16* HY, float* out, int item, LAS float* L, int tid) {
    const int head = item & 15, b = item >> 4, g = head >> 3;
    const int p = tid >> 2, nq = tid & 3;
    LAS float* xs = L; LAS float* Bs = L + 1024; LAS float* Cs = L + 3328; LAS float* dts = L + 5632; LAS float* as_ = L + 5648;
    float hst[32];
#pragma unroll
    for (int i = 0; i < 32; ++i) hst[i] = 0.f;
    const float dsk = dskip[head];
    for (int t0 = 0; t0 < SEQ; t0 += 16) {
        __syncthreads();
        const size_t row0 = (size_t)b * SEQ + t0;
        for (int e = tid; e < 16 * 64; e += 256) { const int tt = e >> 6, pp = e & 63; xs[e] = bf2f(XC[(row0 + tt) * CONVD + head * 64 + pp]); }
        for (int e = tid; e < 16 * 128; e += 256) { const int tt = e >> 7, n = e & 127;
            Bs[(tt * 4 + (n >> 5)) * 36 + (n & 31)] = bf2f(XC[(row0 + tt) * CONVD + 1024 + g * 128 + n]);
            Cs[(tt * 4 + (n >> 5)) * 36 + (n & 31)] = bf2f(XC[(row0 + tt) * CONVD + 1280 + g * 128 + n]); }
        if (tid < 16) { dts[tid] = G[(row0 + tid) * GW + 8 + head]; as_[tid] = G[(row0 + tid) * GW + 24 + head]; }
        __syncthreads();
        for (int tt = 0; tt < 16; ++tt) {
            const float decay = expf(as_[tt]), xv = xs[tt * 64 + p], coef = dts[tt] * xv;
            float acc = 0.f;
#pragma unroll
            for (int i = 0; i < 32; ++i) { hst[i] = decay * hst[i] + coef * Bs[(tt * 4 + nq) * 36 + i]; acc += Cs[(tt * 4 + nq) * 36 + i] * hst[i]; }
            acc += __shfl_xor(acc, 1); acc += __shfl_xor(acc, 2);
            if (nq == 0) HY[(row0 + tt) * MIX + 1024 + head * 64 + p] = (bf16)f2bf(acc + dsk * xv);
        }
    }
#pragma unroll
    for (int i = 0; i < 32; ++i) out[O_SSP + ((size_t)(b * SH + head) * SP + p) * SN + nq * 32 + i] = hst[i];
}

__device__ __forceinline__ void ssd_sample_item(const bf16* XC, const float* G, const float* dskip, const float* sin_, bf16* HY, float* out, int item, int tid) {
    const int head = item & 15, b = item >> 4, g = head >> 3;
    const int pj = tid >> 5, n4 = tid & 31;
    const size_t row = (size_t)MP + b;
    const float dt = G[row * GW + 8 + head], decay = expf(G[row * GW + 24 + head]), dsk = dskip[head];
    const f32x4 B4 = ld_bf4(XC + row * CONVD + 1024 + g * 128 + 4 * n4), C4 = ld_bf4(XC + row * CONVD + 1280 + g * 128 + 4 * n4);
#pragma unroll
    for (int j = 0; j < 8; ++j) {
        const int p = pj + 8 * j;
        const float xv = bf2f(XC[row * CONVD + head * 64 + p]);
        const size_t off = ((size_t)(b * SH + head) * SP + p) * SN + 4 * n4;
        const f32x4 hn = *(const f32x4*)(sin_ + off) * decay + B4 * (dt * xv);
        *(f32x4*)(out + O_SSS + off) = hn;
        float acc = C4.x * hn.x + C4.y * hn.y + C4.z * hn.z + C4.w * hn.w;
#pragma unroll
        for (int o = 1; o < 32; o <<= 1) acc += __shfl_xor(acc, o);
        if (n4 == 0) HY[row * MIX + 1024 + head * 64 + p] = (bf16)f2bf(acc + dsk * xv);
    }
}

__device__ __forceinline__ void finish_phase(const bf16* proj, const float* gml, const float* gssm, bf16* HY, int gw, int ngw, int lane) {
    for (int r = gw; r < MPAD; r += ngw) {
        bf16* hy = HY + (size_t)r * MIX;
        if (r >= MR) {
#pragma unroll
            for (int j = 0; j < 8; ++j) *(u32x2*)(hy + 4 * lane + 256 * j) = (u32x2){0u, 0u};
            continue; }
        const bf16* pr = proj + (size_t)r * NIN;
        f32x4 v[8]; float ss[8];
#pragma unroll
        for (int j = 0; j < 8; ++j) {
            v[j] = ld_bf4(hy + 4 * lane + 256 * j);
            if (j >= 4) { const f32x4 z = ld_bf4(pr + PZ + 4 * lane + 256 * (j - 4)); v[j].x *= silu_x(z.x); v[j].y *= silu_x(z.y); v[j].z *= silu_x(z.z); v[j].w *= silu_x(z.w); }
            ss[j] = wave_sum(v[j].x * v[j].x + v[j].y * v[j].y + v[j].z * v[j].z + v[j].w * v[j].w);
        }
#pragma unroll
        for (int j = 0; j < 8; ++j) {
            const int col = 4 * lane + 256 * j;
            f32x4 o;
            if (j < 4) {
                const float rstd = 1.0f / sqrtf(ss[j] * (1.0f / 256.0f) + EPS);
                const f32x4 gg = *(const f32x4*)(gml + col), og = ld_bf4(pr + PO + col);
                o = v[j] * rstd * gg; o.x *= sigmoid_f(og.x); o.y *= sigmoid_f(og.y); o.z *= sigmoid_f(og.z); o.w *= sigmoid_f(og.w);
            } else {
                const int j0 = 4 + ((j - 4) & ~1);
                const float rstd = 1.0f / sqrtf((ss[j0] + ss[j0 + 1]) * (1.0f / 512.0f) + EPS);
                o = v[j] * rstd * *(const f32x4*)(gssm + col - 1024);
            }
            st_bf4(hy + col, o);
        }
    }
}

__device__ __forceinline__ void rowpass_phase(const float* xp, const float* xs, const float* xin, const float* outf, const float* slab, int nks, const float* gpost, const float* gnext,
                                              float* xout, bf16* UB, float* UF, int gw, int ngw, int lane) {
    for (int r = gw; r < MPAD; r += ngw) {
        if (r >= MR) {
            if (UB) {
#pragma unroll
                for (int j = 0; j < 4; ++j) *(u32x2*)(UB + (size_t)r * D + 4 * lane + 256 * j) = (u32x2){0u, 0u}; }
            continue; }
        const float* xi = xin ? xin + (size_t)r * D : x_row(xp, xs, r);
        f32x4 o[4], x[4]; float ss = 0.f;
#pragma unroll
        for (int j = 0; j < 4; ++j) { x[j] = *(const f32x4*)(xi + 4 * lane + 256 * j);
            if (r < MP) o[j] = *(const f32x4*)(outf + (size_t)r * D + 4 * lane + 256 * j);
            else { o[j] = (f32x4){0.f, 0.f, 0.f, 0.f}; for (int ks = 0; ks < nks; ++ks) o[j] += *(const f32x4*)(slab + ((size_t)ks * 128 + (r - MP)) * D + 4 * lane + 256 * j); }
            ss += o[j].x * o[j].x + o[j].y * o[j].y + o[j].z * o[j].z + o[j].w * o[j].w; }
        const float rstd = 1.0f / sqrtf(wave_sum(ss) * (1.0f / D) + EPS);
        float ss2 = 0.f;
#pragma unroll
        for (int j = 0; j < 4; ++j) { x[j] += o[j] * rstd * *(const f32x4*)(gpost + 4 * lane + 256 * j); *(f32x4*)(xout + (size_t)r * D + 4 * lane + 256 * j) = x[j];
            ss2 += x[j].x * x[j].x + x[j].y * x[j].y + x[j].z * x[j].z + x[j].w * x[j].w; }
        if (gnext) {
            const float rstd2 = 1.0f / sqrtf(wave_sum(ss2) * (1.0f / D) + EPS);
#pragma unroll
            for (int j = 0; j < 4; ++j) { const f32x4 u = x[j] * rstd2 * *(const f32x4*)(gnext + 4 * lane + 256 * j);
                if (UB) st_bf4(UB + (size_t)r * D + 4 * lane + 256 * j, u);
                if (UF) *(f32x4*)(UF + (size_t)r * D + 4 * lane + 256 * j) = u; }
        }
    }
}

__device__ __forceinline__ void pool_phase(const float* U2F, const float* spool, bf16* DP, float* out, size_t t0, size_t nthr) {
    for (size_t i = t0; i < (size_t)MPAD * (D / 4); i += nthr) {
        const int r = (int)(i / (D / 4)), c = 4 * (int)(i % (D / 4));
        if (r >= MR) { *(u32x2*)(DP + (size_t)r * D + c) = (u32x2){0u, 0u}; continue; }
        const int w = 2 << (c >> 8);
        const f32x4 u = *(const f32x4*)(U2F + (size_t)r * D + c);
        f32x4 s = u; float cnt;
        if (r < MP) { const int t = r & (SEQ - 1); const int n = (t + 1 < w) ? t + 1 : w; cnt = (float)n;
#pragma unroll
            for (int k = 1; k < 16; ++k) if (k < n) s += *(const f32x4*)(U2F + (size_t)(r - k) * D + c); }
        else { const int b = r - MP; cnt = (float)w;
#pragma unroll
            for (int k = 1; k < 16; ++k) if (k < w) s += *(const f32x4*)(spool + ((size_t)b * 15 + 15 - k) * D + c); }
        st_bf4(DP + (size_t)r * D + c, s / cnt - u);
    }
    for (size_t i = t0; i < (size_t)BATCH * 15 * (D / 4); i += nthr) {
        const int c = 4 * (int)(i % (D / 4)), j = (int)(i / (D / 4)) % 15, b = (int)(i / (D / 4)) / 15;
        *(f32x4*)(out + O_PLP + ((size_t)b * 15 + j) * D + c) = *(const f32x4*)(U2F + (size_t)(b * SEQ + SEQ - 15 + j) * D + c);
    }
    for (size_t i = t0; i < (size_t)MS * 15 * (D / 4); i += nthr) {
        const int c = 4 * (int)(i % (D / 4)), j = (int)(i / (D / 4)) % 15, b = (int)(i / (D / 4)) / 15;
        f32x4 v; if (j < 14) v = *(const f32x4*)(spool + ((size_t)b * 15 + j + 1) * D + c); else v = *(const f32x4*)(U2F + (size_t)(MP + b) * D + c);
        *(f32x4*)(out + O_PLS + ((size_t)b * 15 + j) * D + c) = v;
    }
}
typedef short bf16x8 __attribute__((ext_vector_type(8)));
typedef short s16x4 __attribute__((ext_vector_type(4)));
typedef short v4i16_t __attribute__((ext_vector_type(4)));
__device__ __forceinline__ bf16x8 rowfrag(const LAS unsigned char* img, int ld, int row0, int k0, int fr, int fq) {
    return *(const LAS bf16x8*)(img + (row0 + fr) * ld + (k0 + 8 * fq) * 2);
}
__device__ __forceinline__ s16x4 vtr(const LAS unsigned char* p) { return __builtin_bit_cast(s16x4, __builtin_amdgcn_ds_read_tr16_b64_v4i16((LAS v4i16_t*)p)); }
__device__ __forceinline__ bf16x8 trfrag(const LAS unsigned char* img, int ld, int k0, int m0, int fr, int fq) {
    const LAS unsigned char* a = img + (k0 + 8 * fq + (fr >> 2)) * ld + (m0 + 4 * (fr & 3)) * 2;
    const s16x4 lo = vtr(a), hi = vtr(a + 4 * ld);
    return (bf16x8){lo[0], lo[1], lo[2], lo[3], hi[0], hi[1], hi[2], hi[3]};
}
__device__ __forceinline__ bf16x8 scale8(bf16x8 x, f32x4 w0, f32x4 w1) {
    u32x4 r;
    r.x = pg8::cvt_pk_bf16(bf2f((unsigned short)x[0]) * w0.x, bf2f((unsigned short)x[1]) * w0.y);
    r.y = pg8::cvt_pk_bf16(bf2f((unsigned short)x[2]) * w0.z, bf2f((unsigned short)x[3]) * w0.w);
    r.z = pg8::cvt_pk_bf16(bf2f((unsigned short)x[4]) * w1.x, bf2f((unsigned short)x[5]) * w1.y);
    r.w = pg8::cvt_pk_bf16(bf2f((unsigned short)x[6]) * w1.z, bf2f((unsigned short)x[7]) * w1.w);
    return __builtin_bit_cast(bf16x8, r);
}
#define MFMA16(a, b, c) __builtin_amdgcn_mfma_f32_16x16x32_bf16((a), (b), (c), 0, 0, 0)

namespace ms {
constexpr int LDQ = 528, LDV = 144;
constexpr int Q = 0, K = Q + 64 * LDQ, VT = K + 64 * LDQ, P = VT + 80 * LDV, CT = P + 64 * LDV, GA = CT + 80 * LDQ;
constexpr int END = GA + (5 * 64 + 16) * 4;
}
__device__ __forceinline__ void mlstm_scan_mfma(const bf16* proj, const float* G, bf16* HY, float* out, int job, LAS unsigned char* L, int tid) {
    const int vq = job & 3, h = (job >> 2) & 3, b = job >> 4;
    const int lane = tid & 63, w = __builtin_amdgcn_readfirstlane(tid >> 6), fr = lane & 15, fq = lane >> 4;
    LAS float* A_ = (LAS float*)(L + ms::GA); LAS float* MX = A_ + 64; LAS float* IW = A_ + 128; LAS float* W_ = A_ + 192; LAS float* EMT = A_ + 256; LAS float* SC = A_ + 320;
    __syncthreads();
    for (int i = tid; i < 80 * ms::LDQ / 16; i += NTHREADS) *(LAS u32x4*)(L + ms::CT + 16 * i) = (u32x4){0u, 0u, 0u, 0u};
    for (int i = tid; i < 16 * ms::LDV / 4; i += NTHREADS) ((LAS unsigned*)(L + ms::VT + 64 * ms::LDV))[i] = (i < 32) ? 0x3F803F80u : 0u;
    f32x4 acc[2][5];
#pragma unroll
    for (int a = 0; a < 2; ++a)
#pragma unroll
        for (int v = 0; v < 5; ++v) acc[a][v] = (f32x4){0.f, 0.f, 0.f, 0.f};
    float m_run = 0.f;
    u32x4 rq[4], rk[4], rv; float rli = 0.f, rlf = 0.f;
    const int prow = tid >> 5, pc16 = tid & 31, vrow = tid >> 3, vc = tid & 7;
#define ML_LOAD(j) do { const size_t r0_ = (size_t)b * SEQ + 64 * (j); \
        _Pragma("unroll") for (int i = 0; i < 4; ++i) { const bf16* p_ = proj + (r0_ + prow + 16 * i) * NIN + h * 256 + pc16 * 8; rq[i] = *(const u32x4*)(p_ + PQ); rk[i] = *(const u32x4*)(p_ + PK); } \
        rv = *(const u32x4*)(proj + (r0_ + vrow) * NIN + PV + h * 256 + vq * 64 + vc * 8); \
        if (w == 0) { rli = G[(r0_ + lane) * GW + h]; rlf = G[(r0_ + lane) * GW + 4 + h]; } } while (0)
#define ML_STORE() do { \
        _Pragma("unroll") for (int i = 0; i < 4; ++i) { *(LAS u32x4*)(L + ms::Q + (prow + 16 * i) * ms::LDQ + pc16 * 16) = rq[i]; *(LAS u32x4*)(L + ms::K + (prow + 16 * i) * ms::LDQ + pc16 * 16) = rk[i]; } \
        { LAS unsigned short* vt_ = (LAS unsigned short*)(L + ms::VT + (8 * vc) * ms::LDV + vrow * 2); \
          vt_[0 * (ms::LDV / 2)] = (unsigned short)(rv.x & 0xffffu); vt_[1 * (ms::LDV / 2)] = (unsigned short)(rv.x >> 16); vt_[2 * (ms::LDV / 2)] = (unsigned short)(rv.y & 0xffffu); vt_[3 * (ms::LDV / 2)] = (unsigned short)(rv.y >> 16); \
          vt_[4 * (ms::LDV / 2)] = (unsigned short)(rv.z & 0xffffu); vt_[5 * (ms::LDV / 2)] = (unsigned short)(rv.z >> 16); vt_[6 * (ms::LDV / 2)] = (unsigned short)(rv.w & 0xffffu); vt_[7 * (ms::LDV / 2)] = (unsigned short)(rv.w >> 16); } \
        if (w == 0) { float bb = rlf; \
            _Pragma("unroll") for (int o = 1; o < 64; o <<= 1) { const float v_ = __shfl_up(bb, o); if (lane >= o) bb += v_; } \
            const float a_ = rli - bb; float pm = a_; \
            _Pragma("unroll") for (int o = 1; o < 64; o <<= 1) { const float v_ = __shfl_up(pm, o); if (lane >= o) pm = fmaxf(pm, v_); } \
            const float mx = fmaxf(m_run, pm), iw = __expf(m_run - mx); \
            const float mx63 = __shfl(mx, 63), b63 = __shfl(bb, 63); \
            A_[lane] = a_; MX[lane] = mx; IW[lane] = iw; W_[lane] = __expf(a_ - mx63); EMT[lane] = __expf(-(bb + mx)); \
            if (lane == 63) SC[0] = iw; \
            m_run = b63 + mx63; } } while (0)
    ML_LOAD(0);
    ML_STORE();
    __syncthreads();
    for (int j = 0; j < SEQ / 64; ++j) {
        const size_t row0 = (size_t)b * SEQ + 64 * j;
        if (j + 1 < SEQ / 64) ML_LOAD(j + 1);
        {
            const int tt = w >> 1;
            const float mxt = MX[16 * tt + fr];
#pragma unroll
            for (int sti = 0; sti < 2; ++sti) {
                const int st = 2 * (w & 1) + sti;
                u32x2 pk = (u32x2){0u, 0u};
                if (st <= tt) {
                    f32x4 s = (f32x4){0.f, 0.f, 0.f, 0.f};
#pragma unroll
                    for (int ks = 0; ks < 8; ++ks) s = MFMA16(rowfrag(L + ms::K, ms::LDQ, 16 * st, 32 * ks, fr, fq), rowfrag(L + ms::Q, ms::LDQ, 16 * tt, 32 * ks, fr, fq), s);
                    const f32x4 a4 = *(const LAS f32x4*)(A_ + 16 * st + 4 * fq);
                    const int t = 16 * tt + fr, s0 = 16 * st + 4 * fq;
                    const float p0 = (s0 + 0 <= t) ? s[0] * __expf(a4[0] - mxt) : 0.f;
                    const float p1 = (s0 + 1 <= t) ? s[1] * __expf(a4[1] - mxt) : 0.f;
                    const float p2 = (s0 + 2 <= t) ? s[2] * __expf(a4[2] - mxt) : 0.f;
                    const float p3 = (s0 + 3 <= t) ? s[3] * __expf(a4[3] - mxt) : 0.f;
                    pk.x = pg8::cvt_pk_bf16(p0, p1); pk.y = pg8::cvt_pk_bf16(p2, p3);
                }
                *(LAS u32x2*)(L + ms::P + (16 * tt + fr) * ms::LDV + (16 * st + 4 * fq) * 2) = pk;
            }
            const float dec = SC[0];
#pragma unroll
            for (int a = 0; a < 2; ++a)
#pragma unroll
                for (int v = 0; v < 5; ++v) acc[a][v] *= dec;
#pragma unroll
            for (int ks = 0; ks < 2; ++ks) {
                const f32x4 w0 = *(const LAS f32x4*)(W_ + 32 * ks + 8 * fq), w1 = *(const LAS f32x4*)(W_ + 32 * ks + 8 * fq + 4);
                bf16x8 bfr[5];
#pragma unroll
                for (int v = 0; v < 5; ++v) bfr[v] = rowfrag(L + ms::VT, ms::LDV, 16 * v, 32 * ks, fr, fq);
#pragma unroll
                for (int a = 0; a < 2; ++a) {
                    const bf16x8 kf = scale8(trfrag(L + ms::K, ms::LDQ, 32 * ks, 16 * (2 * w + a), fr, fq), w0, w1);
#pragma unroll
                    for (int v = 0; v < 5; ++v) acc[a][v] = MFMA16(kf, bfr[v], acc[a][v]);
                }
            }
        }
        __syncthreads();
        {
            const int tt = w & 3, t = 16 * tt + fr, vb = (w < 4) ? 0 : 2;
            f32x4 n2[3], n1[3];
#pragma unroll
            for (int i = 0; i < 3; ++i) { n2[i] = (f32x4){0.f, 0.f, 0.f, 0.f}; n1[i] = (f32x4){0.f, 0.f, 0.f, 0.f}; }
#pragma unroll
            for (int ks = 0; ks < 8; ++ks) {
                const bf16x8 bq = rowfrag(L + ms::Q, ms::LDQ, 16 * tt, 32 * ks, fr, fq);
#pragma unroll
                for (int i = 0; i < 3; ++i) n2[i] = MFMA16(rowfrag(L + ms::CT, ms::LDQ, 16 * (i < 2 ? vb + i : 4), 32 * ks, fr, fq), bq, n2[i]);
            }
#pragma unroll
            for (int ks = 0; ks < 2; ++ks) {
                if (32 * ks <= 16 * tt + 15) {
                    const bf16x8 bp = rowfrag(L + ms::P, ms::LDV, 16 * tt, 32 * ks, fr, fq);
#pragma unroll
                    for (int i = 0; i < 3; ++i) n1[i] = MFMA16(rowfrag(L + ms::VT, ms::LDV, 16 * (i < 2 ? vb + i : 4), 32 * ks, fr, fq), bp, n1[i]);
                }
            }
            const float iwt = IW[t];
            const float den = __shfl(n1[2][0] + iwt * n2[2][0], fr);
            const float sc = 1.0f / fmaxf(fabsf(den), EMT[t]);
#pragma unroll
            for (int i = 0; i < 2; ++i) {
                const f32x4 hv = (n1[i] + n2[i] * iwt) * sc;
                u32x2 pk; pk.x = pg8::cvt_pk_bf16(hv[0], hv[1]); pk.y = pg8::cvt_pk_bf16(hv[2], hv[3]);
                *(u32x2*)(HY + (row0 + t) * MIX + h * 256 + vq * 64 + 16 * (vb + i) + 4 * fq) = pk;
            }
        }
        __syncthreads();
#pragma unroll
        for (int a = 0; a < 2; ++a)
#pragma unroll
            for (int v = 0; v < 5; ++v) { u32x2 pk; pk.x = pg8::cvt_pk_bf16(acc[a][v][0], acc[a][v][1]); pk.y = pg8::cvt_pk_bf16(acc[a][v][2], acc[a][v][3]);
                *(LAS u32x2*)(L + ms::CT + (16 * v + fr) * ms::LDQ + (32 * w + 16 * a + 4 * fq) * 2) = pk; }
        if (j + 1 < SEQ / 64) ML_STORE();
        __syncthreads();
    }
#undef ML_LOAD
#undef ML_STORE
#pragma unroll
    for (int a = 0; a < 2; ++a)
#pragma unroll
        for (int v = 0; v < 4; ++v)
#pragma unroll
            for (int jj = 0; jj < 4; ++jj) out[O_CP + ((size_t)(b * MH + h) * MDK + 32 * w + 16 * a + 4 * fq + jj) * MDV + vq * 64 + 16 * v + fr] = acc[a][v][jj];
    if (vq == 0) {
        if (fr == 0) {
#pragma unroll
            for (int a = 0; a < 2; ++a)
#pragma unroll
                for (int jj = 0; jj < 4; ++jj) out[O_NP + (size_t)(b * MH + h) * MDK + 32 * w + 16 * a + 4 * fq + jj] = acc[a][4][jj];
        }
        if (tid == 0) out[O_MP + b * MH + h] = m_run;
    }
}

namespace ss {
constexpr int LDN = 272, LDS_ = 144;
constexpr int BS = 0, CS = BS + 64 * LDN, XT = CS + 64 * LDN, PS = XT + 64 * LDS_, HB = PS + 64 * LDS_, GA = HB + 64 * LDN;
constexpr int END = GA + (4 * 64 + 16) * 4;
}
__device__ __forceinline__ void ssd_scan_mfma(const bf16* XC, const float* G, const float* dskip, bf16* HY, float* out, int job, LAS unsigned char* L, int tid) {
    const int head = job & 15, b = job >> 4, g = head >> 3;
    const int lane = tid & 63, w = __builtin_amdgcn_readfirstlane(tid >> 6), fr = lane & 15, fq = lane >> 4;
    LAS float* CUM = (LAS float*)(L + ss::GA); LAS float* DT = CUM + 64; LAS float* ECUM = CUM + 128; LAS float* WEND = CUM + 192; LAS float* SC = CUM + 256;
    __syncthreads();
    for (int i = tid; i < 64 * ss::LDN / 16; i += NTHREADS) *(LAS u32x4*)(L + ss::HB + 16 * i) = (u32x4){0u, 0u, 0u, 0u};
    f32x4 acc[4];
#pragma unroll
    for (int p = 0; p < 4; ++p) acc[p] = (f32x4){0.f, 0.f, 0.f, 0.f};
    const float dsk = dskip[head];
    u32x4 rb[2], rc[2], rx; float rdt = 0.f, ra = 0.f;
    const int prow = tid >> 4, pc16 = tid & 15, xrow = tid >> 3, xc = tid & 7;
#define SS_LOAD(j) do { const size_t r0_ = (size_t)b * SEQ + 64 * (j); \
        _Pragma("unroll") for (int i = 0; i < 2; ++i) { const bf16* p_ = XC + (r0_ + prow + 32 * i) * CONVD + g * 128 + pc16 * 8; rb[i] = *(const u32x4*)(p_ + 1024); rc[i] = *(const u32x4*)(p_ + 1280); } \
        rx = *(const u32x4*)(XC + (r0_ + xrow) * CONVD + head * 64 + xc * 8); \
        if (w == 0) { rdt = G[(r0_ + lane) * GW + 8 + head]; ra = G[(r0_ + lane) * GW + 24 + head]; } } while (0)
#define SS_STORE() do { \
        _Pragma("unroll") for (int i = 0; i < 2; ++i) { *(LAS u32x4*)(L + ss::BS + (prow + 32 * i) * ss::LDN + pc16 * 16) = rb[i]; *(LAS u32x4*)(L + ss::CS + (prow + 32 * i) * ss::LDN + pc16 * 16) = rc[i]; } \
        { LAS unsigned short* xt_ = (LAS unsigned short*)(L + ss::XT + (8 * xc) * ss::LDS_ + xrow * 2); \
          xt_[0 * (ss::LDS_ / 2)] = (unsigned short)(rx.x & 0xffffu); xt_[1 * (ss::LDS_ / 2)] = (unsigned short)(rx.x >> 16); xt_[2 * (ss::LDS_ / 2)] = (unsigned short)(rx.y & 0xffffu); xt_[3 * (ss::LDS_ / 2)] = (unsigned short)(rx.y >> 16); \
          xt_[4 * (ss::LDS_ / 2)] = (unsigned short)(rx.z & 0xffffu); xt_[5 * (ss::LDS_ / 2)] = (unsigned short)(rx.z >> 16); xt_[6 * (ss::LDS_ / 2)] = (unsigned short)(rx.w & 0xffffu); xt_[7 * (ss::LDS_ / 2)] = (unsigned short)(rx.w >> 16); } \
        if (w == 0) { float cs = ra; \
            _Pragma("unroll") for (int o = 1; o < 64; o <<= 1) { const float v_ = __shfl_up(cs, o); if (lane >= o) cs += v_; } \
            const float c63 = __shfl(cs, 63); \
            CUM[lane] = cs; DT[lane] = rdt; ECUM[lane] = __expf(cs); WEND[lane] = __expf(c63 - cs) * rdt; \
            if (lane == 63) SC[0] = __expf(cs); } } while (0)
    SS_LOAD(0);
    SS_STORE();
    __syncthreads();
    for (int j = 0; j < SEQ / 64; ++j) {
        const size_t row0 = (size_t)b * SEQ + 64 * j;
        if (j + 1 < SEQ / 64) SS_LOAD(j + 1);
        {
            const int tt = w >> 1;
            const float cumt = CUM[16 * tt + fr];
#pragma unroll
            for (int sti = 0; sti < 2; ++sti) {
                const int st = 2 * (w & 1) + sti;
                u32x2 pk = (u32x2){0u, 0u};
                if (st <= tt) {
                    f32x4 s = (f32x4){0.f, 0.f, 0.f, 0.f};
#pragma unroll
                    for (int ks = 0; ks < 4; ++ks) s = MFMA16(rowfrag(L + ss::BS, ss::LDN, 16 * st, 32 * ks, fr, fq), rowfrag(L + ss::CS, ss::LDN, 16 * tt, 32 * ks, fr, fq), s);
                    const f32x4 c4 = *(const LAS f32x4*)(CUM + 16 * st + 4 * fq), d4 = *(const LAS f32x4*)(DT + 16 * st + 4 * fq);
                    const int t = 16 * tt + fr, s0 = 16 * st + 4 * fq;
                    const float p0 = (s0 + 0 <= t) ? s[0] * __expf(cumt - c4[0]) * d4[0] : 0.f;
                    const float p1 = (s0 + 1 <= t) ? s[1] * __expf(cumt - c4[1]) * d4[1] : 0.f;
                    const float p2 = (s0 + 2 <= t) ? s[2] * __expf(cumt - c4[2]) * d4[2] : 0.f;
                    const float p3 = (s0 + 3 <= t) ? s[3] * __expf(cumt - c4[3]) * d4[3] : 0.f;
                    pk.x = pg8::cvt_pk_bf16(p0, p1); pk.y = pg8::cvt_pk_bf16(p2, p3);
                }
                *(LAS u32x2*)(L + ss::PS + (16 * tt + fr) * ss::LDS_ + (16 * st + 4 * fq) * 2) = pk;
            }
            const float dec = SC[0];
#pragma unroll
            for (int p = 0; p < 4; ++p) acc[p] *= dec;
#pragma unroll
            for (int ks = 0; ks < 2; ++ks) {
                const f32x4 w0 = *(const LAS f32x4*)(WEND + 32 * ks + 8 * fq), w1 = *(const LAS f32x4*)(WEND + 32 * ks + 8 * fq + 4);
                const bf16x8 bf = scale8(trfrag(L + ss::BS, ss::LDN, 32 * ks, 16 * w, fr, fq), w0, w1);
#pragma unroll
                for (int p = 0; p < 4; ++p) acc[p] = MFMA16(bf, rowfrag(L + ss::XT, ss::LDS_, 16 * p, 32 * ks, fr, fq), acc[p]);
            }
        }
        __syncthreads();
        {
            const int tt = w & 3, t = 16 * tt + fr, pb = 2 * (w >> 2);
            f32x4 n2[2], n1[2];
#pragma unroll
            for (int i = 0; i < 2; ++i) { n2[i] = (f32x4){0.f, 0.f, 0.f, 0.f}; n1[i] = (f32x4){0.f, 0.f, 0.f, 0.f}; }
#pragma unroll
            for (int ks = 0; ks < 4; ++ks) {
                const bf16x8 bc = rowfrag(L + ss::CS, ss::LDN, 16 * tt, 32 * ks, fr, fq);
#pragma unroll
                for (int i = 0; i < 2; ++i) n2[i] = MFMA16(rowfrag(L + ss::HB, ss::LDN, 16 * (pb + i), 32 * ks, fr, fq), bc, n2[i]);
            }
#pragma unroll
            for (int ks = 0; ks < 2; ++ks) {
                if (32 * ks <= 16 * tt + 15) {
                    const bf16x8 bp = rowfrag(L + ss::PS, ss::LDS_, 16 * tt, 32 * ks, fr, fq);
#pragma unroll
                    for (int i = 0; i < 2; ++i) n1[i] = MFMA16(rowfrag(L + ss::XT, ss::LDS_, 16 * (pb + i), 32 * ks, fr, fq), bp, n1[i]);
                }
            }
            const float ec = ECUM[t];
#pragma unroll
            for (int i = 0; i < 2; ++i) {
                const int p0 = 16 * (pb + i) + 4 * fq;
                f32x4 y = n1[i] + n2[i] * ec;
#pragma unroll
                for (int jj = 0; jj < 4; ++jj) y[jj] += dsk * bf2f(*(const LAS unsigned short*)(L + ss::XT + (p0 + jj) * ss::LDS_ + t * 2));
                u32x2 pk; pk.x = pg8::cvt_pk_bf16(y[0], y[1]); pk.y = pg8::cvt_pk_bf16(y[2], y[3]);
                *(u32x2*)(HY + (row0 + t) * MIX + 1024 + head * 64 + p0) = pk;
            }
        }
        __syncthreads();
#pragma unroll
        for (int p = 0; p < 4; ++p) { u32x2 pk; pk.x = pg8::cvt_pk_bf16(acc[p][0], acc[p][1]); pk.y = pg8::cvt_pk_bf16(acc[p][2], acc[p][3]);
            *(LAS u32x2*)(L + ss::HB + (16 * p + fr) * ss::LDN + (16 * w + 4 * fq) * 2) = pk; }
        if (j + 1 < SEQ / 64) SS_STORE();
        __syncthreads();
    }
#undef SS_LOAD
#undef SS_STORE
#pragma unroll
    for (int p = 0; p < 4; ++p)
#pragma unroll
        for (int jj = 0; jj < 4; ++jj) out[O_SSP + ((size_t)(b * SH + head) * SP + 16 * p + fr) * SN + 16 * w + 4 * fq + jj] = acc[p][jj];
}
struct Args { const float* in[N_IN]; float* out; unsigned char* ws; };
__global__ void __launch_bounds__(NTHREADS, 2) mega_fwd(Args args) {
    extern __shared__ __attribute__((aligned(16))) unsigned char lds_raw[];
    LAS unsigned char* lds = (LAS unsigned char*)lds_raw;
    const int tid = threadIdx.x, lane = tid & 63, wave = __builtin_amdgcn_readfirstlane(tid >> 6);
    const int G = gridDim.x, bx = blockIdx.x;
    const int vcu = (G % 8 == 0) ? (bx % 8) * (G / 8) + bx / 8 : bx;
    const int gw = vcu * NWAVES + wave, ngw = G * NWAVES;
    const size_t gt = (size_t)vcu * NTHREADS + tid, ngt = (size_t)G * NTHREADS;
    unsigned char* ws = args.ws; float* out = args.out;
    const float* const* in = args.in;
    gu32* ctl = (gu32*)(ws + WS_CTL);
    for (int u = tid; u < (LDS_BYTES - LDSCTL_OFF) / 4; u += NTHREADS) ((LAS unsigned*)(lds + LDSCTL_OFF))[u] = 0u;
    __syncthreads();
    volatile LAS unsigned* MISC = (volatile LAS unsigned*)(lds + MISC_OFF);
    XcdBarrier bar = xcd_barrier_post((unsigned*)(ctl + CW_BAR), MISC + 8);
    bf16* WIN = (bf16*)(ws + WS_WIN); bf16* WOUT = (bf16*)(ws + WS_WOUT); bf16* WPOOL = (bf16*)(ws + WS_WPOOL);
    bf16* U = (bf16*)(ws + WS_U); float* Gt = (float*)(ws + WS_G); bf16* XC = (bf16*)(ws + WS_XC); bf16* HY = (bf16*)(ws + WS_HY);
    bf16* PROJ = (bf16*)(ws + WS_PROJ); float* OUTF = (float*)(ws + WS_OUTF); bf16* HMID = (bf16*)(ws + WS_HMID); float* U2F = (float*)(ws + WS_U2F); float* SLAB = (float*)(ws + WS_SLAB);
    float* Y = out + O_Y;
#define GEMM_PHASE(EPI, gA, gB, gN, gK, glda, gldb, gpn, epi) do { pg8::Gemm g_{gA, gB, MPAD, gN, gK, glda, gldb, gpn, 0, 0}; pg8::StaticOrder S_; S_.init(MPAD, gN, G, bx); \
        pg8::gemm_phase<EPI, pg8::StaticOrder, true, true>(lds + RING_OFF, g_, S_, epi); } while (0)
#define GEMM_PHASE_N1K(gA, gB, gK, glda, gldb, gpn, gnks, gksl) do { \
        { pg8::Gemm g_{gA, gB, MP, D, gK, glda, gldb, gpn, 0, 0}; pg8::StaticOrder S_; S_.init(MP, D, G, bx); \
          pg8::gemm_phase<pg8::EpiF32, pg8::StaticOrder, true, true>(lds + RING_OFF, g_, S_, (pg8::EpiF32{OUTF, D, 0})); } \
        { pg8::Gemm g_{gA, gB, MPAD, D, 256, glda, gldb, gpn, gksl, 0}; pg8::SliceOrder S_{4, gnks, G, bx, MP / 256}; \
          pg8::gemm_phase<pg8::EpiSlab, pg8::SliceOrder, true, true>(lds + RING_OFF, g_, S_, (pg8::EpiSlab{SLAB, D, 0})); } } while (0)

    prep_phase(in, ws, (LAS float*)(lds + RING_OFF + wave * 16384), gw, ngw, lane);
    norm0_phase(in[I_XP], in[I_XS], in[I_GMIXPRE], U, gw, ngw, lane);
    xcd_barrier(bar);
    GEMM_PHASE(pg8::EpiBf16, U, WIN, NIN, D, D, D, 0, (pg8::EpiBf16{PROJ, NIN, 0}));
    xcd_barrier(bar);
    conv_phase(PROJ, in[I_SCONV], in[I_CONVW], in[I_CONVB], in[I_BIG], in[I_BFG], in[I_DTBIAS], in[I_ALOG], XC, Gt, out, gt, ngt);
    xcd_barrier(bar);
    {
        static_assert(ms::END <= RING_BYTES && ss::END <= RING_BYTES, "scan LDS maps");
        if (vcu < 128) mlstm_scan_mfma(PROJ, Gt, HY, out, vcu, lds + RING_OFF, tid);
        else ssd_scan_mfma(XC, Gt, in[I_DSKIP], HY, out, vcu - 128, lds + RING_OFF, tid);
        __syncthreads();
        const int half = tid >> 8, ht = tid & 255;
        const int hb = vcu * 2 + half, nhb = G * 2;
        for (int it = hb; it < MS * MH; it += nhb) mlstm_sample_item(PROJ, Gt, in[I_SC], in[I_SN], in[I_SM], HY, out, it, (LAS float*)(lds + RING_OFF) + half * 2048, ht);
        for (int it = hb; it < MS * SH; it += nhb) ssd_sample_item(XC, Gt, in[I_DSKIP], in[I_SSSM], HY, out, it, ht);
    }
    xcd_barrier(bar);
    finish_phase(PROJ, in[I_GMLSTM], in[I_GSSM], HY, gw, ngw, lane);
    xcd_barrier(bar);
    GEMM_PHASE_N1K(HY, WOUT, MIX, MIX, MIX, 0, 8, 256);
    xcd_barrier(bar);
    rowpass_phase(in[I_XP], in[I_XS], nullptr, OUTF, SLAB, 8, in[I_GMIXPOST], in[I_GFFNPRE], Y, U, nullptr, gw, ngw, lane);
    xcd_barrier(bar);
    GEMM_PHASE(pg8::EpiSwiGLU, U, (bf16*)(ws + WS_WGU), NGU, D, D, D, 0, (pg8::EpiSwiGLU{HMID, FF, 0}));
    xcd_barrier(bar);
    GEMM_PHASE_N1K(HMID, (bf16*)(ws + WS_WDN), FF, FF, FF, 0, 11, 256);
    xcd_barrier(bar);
    rowpass_phase(in[I_XP], in[I_XS], Y, OUTF, SLAB, 11, in[I_GFFNPOST], in[I_GMIXPRE] + D, Y, nullptr, U2F, gw, ngw, lane);
    xcd_barrier(bar);
    pool_phase(U2F, in[I_SPOOL], U, out, gt, ngt);
    xcd_barrier(bar);
    GEMM_PHASE_N1K(U, WPOOL, 256, D, 256, 256, 1, 0);
    xcd_barrier(bar);
    rowpass_phase(in[I_XP], in[I_XS], Y, OUTF, SLAB, 1, in[I_GMIXPOST] + D, in[I_GFFNPRE] + D, Y, U, nullptr, gw, ngw, lane);
    xcd_barrier(bar);
    GEMM_PHASE(pg8::EpiSwiGLU, U, (bf16*)(ws + WS_WGU + al((size_t)NGU * D * 2)), NGU, D, D, D, 0, (pg8::EpiSwiGLU{HMID, FF, 0}));
    xcd_barrier(bar);
    GEMM_PHASE_N1K(HMID, (bf16*)(ws + WS_WDN + al((size_t)D * FF * 2)), FF, FF, FF, 0, 11, 256);
    xcd_barrier(bar);
    rowpass_phase(in[I_XP], in[I_XS], Y, OUTF, SLAB, 11, in[I_GFFNPOST] + D, nullptr, Y, nullptr, nullptr, gw, ngw, lane);
#undef GEMM_PHASE
}

extern "C" void kernel_launch(void* const* d_in, const int* in_sizes, int n_in, void* d_out, int out_size, void* d_ws, size_t ws_size, hipStream_t stream) {
    static int grid = 0;
    if (grid == 0) {
        if (n_in != N_IN || (size_t)out_size != O_END || ws_size < WS_END) {
            fprintf(stderr, "kernel_launch: unexpected sizes n_in %d out %d ws %zu (need %zu)\n", n_in, out_size, ws_size, (size_t)WS_END); grid = -1; return; }
        int dev = 0, cus = 0, per_cu = 0;
        if (hipGetDevice(&dev) != hipSuccess || hipDeviceGetAttribute(&cus, hipDeviceAttributeMultiprocessorCount, dev) != hipSuccess) { grid = -1; return; }
        if (hipFuncSetAttribute((const void*)mega_fwd, hipFuncAttributeMaxDynamicSharedMemorySize, LDS_BYTES) != hipSuccess) { fprintf(stderr, "kernel_launch: hipFuncSetAttribute failed\n"); grid = -1; return; }
        if (hipOccupancyMaxActiveBlocksPerMultiprocessor(&per_cu, (const void*)mega_fwd, NTHREADS, LDS_BYTES) != hipSuccess || per_cu < 1) {
            fprintf(stderr, "kernel_launch: occupancy query says %d blocks per CU; need 1\n", per_cu); grid = -1; (void)hipGetLastError(); return; }
        grid = cus;
        if (grid != 256) fprintf(stderr, "kernel_launch: note: %d CUs (tuned for 256)\n", grid);
    }
    if (grid < 0) return;
    (void)hipMemsetAsync((char*)d_ws + cfg::WS_CTL, 0, CTL_ZERO_BYTES, stream);
    Args a; memset(&a, 0, sizeof(a));
    for (int i = 0; i < N_IN; ++i) a.in[i] = (const float*)d_in[i];
    a.out = (float*)d_out; a.ws = (unsigned char*)d_ws;
    void* kargs[] = {&a};
    hipError_t e = hipLaunchCooperativeKernel((const void*)mega_fwd, dim3(grid), dim3(NTHREADS), kargs, LDS_BYTES, stream);
    if (e != hipSuccess) fprintf(stderr, "kernel_launch: cooperative launch failed: %s (grid %d)\n", hipGetErrorString(e), grid);
}
```
